# Optimizing an MI355X kernel written in HIP

```python
import math
import jax, jax.numpy as jnp
from jax import lax
import numpy as np

D_MODEL = 1024
BATCH = 8
SEQ = 2048
DEPTH = 2
DEC_BATCH = 128
DEC_SEQ = 1
PAST_LEN = 16384
PAGE_SIZE = 128

N_META = 16
POOL_WIDTH = D_MODEL // 2
POOL_WINDOWS = (2, 4, 8, 16)
POOL_GROUPS = len(POOL_WINDOWS)
POOL_GROUP_IN = POOL_WIDTH // POOL_GROUPS
POOL_GROUP_OUT = D_MODEL // POOL_GROUPS
POOL_HIST = max(POOL_WINDOWS) - 1
SSM_WIDTH = D_MODEL // 2
SSM_GROUP_CH = 16
SSM_GROUPS = SSM_WIDTH // SSM_GROUP_CH
SSM_STATE = 64
D_FF = 2816
CONV_W = 3
RMS_EPS = 1e-6
DT_MIN = 1e-3
DT_MAX = 1e-1
IN_COLS = POOL_WIDTH + SSM_WIDTH + 2 * D_MODEL

kernel_name = "hybrid_pool_s5_convffn_decode_step"


def rmsnorm(x, g):
    xf = x.astype(jnp.float32)
    y = xf * lax.rsqrt(jnp.mean(xf * xf, axis=-1, keepdims=True) + RMS_EPS)
    return (y * g.astype(jnp.float32)).astype(x.dtype)


def pool_mixer(u, hist, start_pos, w_grp, scale):
    L = u.shape[1]
    ext = jnp.concatenate([hist.astype(u.dtype), u], axis=1)
    extf = ext.astype(jnp.float32)
    csum = jnp.pad(jnp.cumsum(extf, axis=1), ((0, 0), (1, 0), (0, 0)))
    ends = csum[:, POOL_HIST + 1:]
    pos = start_pos + jnp.arange(L)
    outs = []
    for g, w in enumerate(POOL_WINDOWS):
        sl = slice(g * POOL_GROUP_IN, (g + 1) * POOL_GROUP_IN)
        begin = csum[:, POOL_HIST + 1 - w:POOL_HIST + 1 - w + L, sl]
        cnt = jnp.minimum(w, pos + 1).astype(jnp.float32)[None, :, None]
        d = (ends[..., sl] - begin) / cnt - extf[:, POOL_HIST:, sl]
        outs.append(jnp.einsum("blc,cd->bld", d, w_grp[g].astype(jnp.float32)))
    y = jnp.concatenate(outs, axis=-1) * scale.astype(jnp.float32)
    return y.astype(u.dtype), ext[:, -POOL_HIST:]


def ssm_mixer(u, h0_re, h0_im, A_re, A_im, log_dt, B_re, B_im, C_re, C_im, D_skip):
    Bsz, L, _ = u.shape
    f32 = jnp.float32
    uf = u.astype(f32).reshape(Bsz, L, SSM_GROUPS, SSM_GROUP_CH)
    dt = jnp.exp(log_dt.astype(f32))[:, None]
    lam_re, lam_im = A_re.astype(f32), A_im.astype(f32)
    mag = jnp.exp(lam_re * dt)
    ab_re = mag * jnp.cos(lam_im * dt)
    ab_im = mag * jnp.sin(lam_im * dt)
    den = lam_re * lam_re + lam_im * lam_im
    nr, ni = ab_re - 1.0, ab_im
    q_re = (nr * lam_re + ni * lam_im) / den
    q_im = (ni * lam_re - nr * lam_im) / den
    Br, Bi = B_re.astype(f32), B_im.astype(f32)
    bb_re = q_re[..., None] * Br - q_im[..., None] * Bi
    bb_im = q_re[..., None] * Bi + q_im[..., None] * Br
    bu_re = jnp.einsum("blgp,gnp->blgn", uf, bb_re)
    bu_im = jnp.einsum("blgp,gnp->blgn", uf, bb_im)
    h0r, h0i = h0_re.astype(f32), h0_im.astype(f32)
    bu_re = bu_re.at[:, 0].add(ab_re * h0r - ab_im * h0i)
    bu_im = bu_im.at[:, 0].add(ab_re * h0i + ab_im * h0r)
    a_re = jnp.broadcast_to(ab_re, bu_re.shape)
    a_im = jnp.broadcast_to(ab_im, bu_im.shape)

    def combine(left, right):
        a1r, a1i, b1r, b1i = left
        a2r, a2i, b2r, b2i = right
        return (a1r * a2r - a1i * a2i, a1r * a2i + a1i * a2r,
                a2r * b1r - a2i * b1i + b2r, a2r * b1i + a2i * b1r + b2i)

    _, _, h_re, h_im = lax.associative_scan(combine, (a_re, a_im, bu_re, bu_im), axis=1)
    y = (jnp.einsum("blgn,gpn->blgp", h_re, C_re.astype(f32))
         - jnp.einsum("blgn,gpn->blgp", h_im, C_im.astype(f32)))
    y = y.reshape(Bsz, L, SSM_WIDTH) + D_skip.astype(f32) * u.astype(f32)
    return y.astype(u.dtype), h_re[:, -1].astype(h0_re.dtype), h_im[:, -1].astype(h0_im.dtype)


def glu_out(y, w_glu):
    z = jax.nn.gelu(y)
    zz = z @ w_glu
    return zz[..., :D_MODEL] * jax.nn.sigmoid(zz[..., D_MODEL:])


def conv_ffn(h, hist, w_up, conv_w, conv_b, w_down):
    L = h.shape[1]
    up = h @ w_up
    g, v = up[..., :D_FF], up[..., D_FF:]
    ext = jnp.concatenate([hist.astype(g.dtype), g], axis=1)
    c = conv_b + conv_w[0] * ext[:, 0:L]
    for k in range(1, CONV_W):
        c = c + conv_w[k] * ext[:, k:k + L]
    out = (jax.nn.gelu(c) * v) @ w_down
    return out, ext[:, -(CONV_W - 1):]


def trunk(x, st_pool, st_re, st_im, st_conv, start_pos, norm1_g, w_in, pool_w, pool_scale,
          ssm_A_re, ssm_A_im, ssm_log_dt, ssm_B_re, ssm_B_im, ssm_C_re, ssm_C_im, ssm_D,
          w_glu, w_out, norm2_g, w_up, conv_w, conv_b, w_down, norm_f_g):
    new_pool, new_re, new_im, new_conv = [], [], [], []
    o_ssm = POOL_WIDTH
    o_gp = POOL_WIDTH + SSM_WIDTH
    o_gs = o_gp + D_MODEL
    for l in range(DEPTH):
        h = rmsnorm(x, norm1_g[l])
        proj = h @ w_in[l]
        u_pool = proj[..., :o_ssm]
        u_ssm = proj[..., o_ssm:o_gp]
        gate_pool = jax.nn.sigmoid(proj[..., o_gp:o_gs])
        gate_ssm = jax.nn.sigmoid(proj[..., o_gs:])
        y_pool, hp = pool_mixer(u_pool, st_pool[l], start_pos, pool_w[l], pool_scale[l])
        y_s, hr, hi = ssm_mixer(u_ssm, st_re[l], st_im[l], ssm_A_re[l], ssm_A_im[l], ssm_log_dt[l],
                                ssm_B_re[l], ssm_B_im[l], ssm_C_re[l], ssm_C_im[l], ssm_D[l])
        y_ssm = glu_out(y_s, w_glu[l])
        x = x + (gate_pool * y_pool + gate_ssm * y_ssm) @ w_out[l]
        h2 = rmsnorm(x, norm2_g[l])
        f, hc = conv_ffn(h2, st_conv[l], w_up[l], conv_w[l], conv_b[l], w_down[l])
        x = x + f
        new_pool.append(hp)
        new_re.append(hr)
        new_im.append(hi)
        new_conv.append(hc)
    y = rmsnorm(x, norm_f_g)
    return y, jnp.stack(new_pool), jnp.stack(new_re), jnp.stack(new_im), jnp.stack(new_conv)


def setup_inputs(seed: int = 0) -> dict:
    key = jax.random.key(seed)
    ks = jax.random.split(key, 32)
    f32 = jnp.float32
    nrm = lambda k, shape, s: jax.random.normal(k, shape, f32) * s
    n_idx = jnp.arange(SSM_STATE, dtype=f32)
    return {
        "x_prompt": nrm(ks[0], (BATCH, SEQ, D_MODEL), 1.0),
        "x_sample": nrm(ks[1], (DEC_BATCH, DEC_SEQ, D_MODEL), 1.0),
        "state_pool": nrm(ks[2], (DEPTH, DEC_BATCH, POOL_HIST, POOL_WIDTH), 1.0),
        "state_ssm_re": nrm(ks[3], (DEPTH, DEC_BATCH, SSM_GROUPS, SSM_STATE), 0.5),
        "state_ssm_im": nrm(ks[4], (DEPTH, DEC_BATCH, SSM_GROUPS, SSM_STATE), 0.5),
        "state_conv": nrm(ks[5], (DEPTH, DEC_BATCH, CONV_W - 1, D_FF), 1.0),
        "meta_tokens": nrm(ks[6], (N_META, D_MODEL), 1.0),
        "norm1_g": 1.0 + nrm(ks[7], (DEPTH, D_MODEL), 0.01),
        "w_in": nrm(ks[8], (DEPTH, D_MODEL, IN_COLS), D_MODEL ** -0.5),
        "pool_w": nrm(ks[9], (DEPTH, POOL_GROUPS, POOL_GROUP_IN, POOL_GROUP_OUT), POOL_GROUP_IN ** -0.5),
        "pool_scale": 1.0 + nrm(ks[10], (DEPTH, D_MODEL), 0.1),
        "ssm_A_re": -0.5 + nrm(ks[11], (DEPTH, SSM_GROUPS, SSM_STATE), 0.01),
        "ssm_A_im": math.pi * n_idx + nrm(ks[12], (DEPTH, SSM_GROUPS, SSM_STATE), 0.01),
        "ssm_log_dt": jax.random.uniform(ks[13], (DEPTH, SSM_GROUPS), f32,
                                         math.log(DT_MIN), math.log(DT_MAX)),
        "ssm_B_re": nrm(ks[14], (DEPTH, SSM_GROUPS, SSM_STATE, SSM_GROUP_CH), SSM_GROUP_CH ** -0.5),
        "ssm_B_im": nrm(ks[15], (DEPTH, SSM_GROUPS, SSM_STATE, SSM_GROUP_CH), SSM_GROUP_CH ** -0.5),
        "ssm_C_re": nrm(ks[16], (DEPTH, SSM_GROUPS, SSM_GROUP_CH, SSM_STATE), SSM_STATE ** -0.5),
        "ssm_C_im": nrm(ks[17], (DEPTH, SSM_GROUPS, SSM_GROUP_CH, SSM_STATE), SSM_STATE ** -0.5),
        "ssm_D": nrm(ks[18], (DEPTH, SSM_WIDTH), 1.0),
        "w_glu": nrm(ks[19], (DEPTH, SSM_WIDTH, 2 * D_MODEL), SSM_WIDTH ** -0.5),
        "w_out": nrm(ks[20], (DEPTH, D_MODEL, D_MODEL), D_MODEL ** -0.5),
        "norm2_g": 1.0 + nrm(ks[21], (DEPTH, D_MODEL), 0.01),
        "w_up": nrm(ks[22], (DEPTH, D_MODEL, 2 * D_FF), D_MODEL ** -0.5),
        "conv_w": nrm(ks[23], (DEPTH, CONV_W, D_FF), CONV_W ** -0.5),
        "conv_b": nrm(ks[24], (DEPTH, D_FF), 0.02),
        "w_down": nrm(ks[25], (DEPTH, D_FF, D_MODEL), D_FF ** -0.5),
        "norm_f_g": 1.0 + nrm(ks[26], (D_MODEL,), 0.01),
    }


def reference(x_prompt, x_sample, state_pool, state_ssm_re, state_ssm_im, state_conv, meta_tokens,
              norm1_g, w_in, pool_w, pool_scale, ssm_A_re, ssm_A_im, ssm_log_dt, ssm_B_re, ssm_B_im,
              ssm_C_re, ssm_C_im, ssm_D, w_glu, w_out, norm2_g, w_up, conv_w, conv_b, w_down, norm_f_g):
    dt = x_prompt.dtype
    bp = x_prompt.shape[0]
    meta = jnp.broadcast_to(meta_tokens.astype(dt)[None], (bp, N_META, D_MODEL))
    xp = jnp.concatenate([meta, x_prompt], axis=1)
    z_pool = jnp.zeros((DEPTH, bp, POOL_HIST, POOL_WIDTH), dt)
    z_ssm = jnp.zeros((DEPTH, bp, SSM_GROUPS, SSM_STATE), dt)
    z_conv = jnp.zeros((DEPTH, bp, CONV_W - 1, D_FF), dt)
    yp, pool_p, re_p, im_p, conv_p = trunk(
        xp, z_pool, z_ssm, z_ssm, z_conv, 0, norm1_g, w_in, pool_w, pool_scale,
        ssm_A_re, ssm_A_im, ssm_log_dt, ssm_B_re, ssm_B_im, ssm_C_re, ssm_C_im, ssm_D,
        w_glu, w_out, norm2_g, w_up, conv_w, conv_b, w_down, norm_f_g)
    y_prompt = yp[:, N_META:]
    y_sample, pool_s, re_s, im_s, conv_s = trunk(
        x_sample, state_pool, state_ssm_re, state_ssm_im, state_conv, PAST_LEN,
        norm1_g, w_in, pool_w, pool_scale,
        ssm_A_re, ssm_A_im, ssm_log_dt, ssm_B_re, ssm_B_im, ssm_C_re, ssm_C_im, ssm_D,
        w_glu, w_out, norm2_g, w_up, conv_w, conv_b, w_down, norm_f_g)
    return (y_prompt, y_sample, pool_p, re_p, im_p, conv_p, pool_s, re_s, im_s, conv_s)
```

```cpp
#include <hip/hip_runtime.h>
#include <cstdio>
#include <cstdint>
namespace pg8 {
#define PG8_LAS __attribute__((address_space(3)))
typedef unsigned short bf16_t;
typedef short bf16x8 __attribute__((ext_vector_type(8)));
typedef float f32x4 __attribute__((ext_vector_type(4)));
typedef unsigned u32x4 __attribute__((ext_vector_type(4)));
constexpr int BM = 256, BK = 64, HALF = 128, HTB = HALF * BK * 2  , STAGE_BYTES = 8 * HTB, NXCD = 8, WGM = 8;

__host__ __device__ __forceinline__ int lds_byte(int r, int c) { const int st = (r >> 4) * 2 + (c >> 5), rr = r & 15, cc = c & 31, ob = rr * 64 + cc * 2; return st * 1024 + (ob ^ (((ob >> 9) & 1) << 5)); }
__host__ __device__ __forceinline__ void stage_rc(int b, int& R, int& C) { const int st = b / 1024, sb = b % 1024, swz = sb ^ (((sb >> 9) & 1) << 5); R = (st >> 1) * 16 + swz / 64; C = (st & 1) * 32 + (swz % 64) / 2; }
__host__ __device__ __forceinline__ int perm32(int rho) { const int n = rho >> 4, i = rho & 15; return 8 * (i >> 2) + 4 * n + (i & 3); }

struct Unit { int pm, pn; };
struct Gemm { const bf16_t* A; const bf16_t* Bt; int M, N, K; };

struct StaticOrder {
    int nM, nN, nwg, G, c;
    __host__ __device__ void init(int M, int N, int G_, int c_) { nM = M / BM; nN = N / BM; nwg = nM * nN; G = G_; c = c_; }
    __host__ __device__ bool next(int i, Unit& u) const {
        const long L = (long)i * G + c; if (L >= nwg) return false;
        int wgid = (int)L; { const int q = nwg / NXCD, r = nwg % NXCD, xcd = wgid % NXCD, off = wgid / NXCD; wgid = (xcd < r ? xcd * (q + 1) : r * (q + 1) + (xcd - r) * q) + off; }
        const int nig = WGM * nN, gid = wgid / nig, fm = gid * WGM, gsz = (nM - fm) < WGM ? (nM - fm) : WGM;
        u.pm = fm + ((wgid % nig) % gsz); u.pn = (wgid % nig) / gsz; return true;
    }
    __device__ __forceinline__ void a_ready(const Unit&) const {}
    __device__ __forceinline__ void done(const Unit&) const {}
};

__device__ __forceinline__ unsigned cvt_pk_bf16(float lo, float hi) { unsigned r; asm volatile("v_cvt_pk_bf16_f32 %0, %1, %2" : "=v"(r) : "v"(lo), "v"(hi)); return r; }
template <class Epi, class Sched, bool ALIGN_EPI = false, bool SP2 = false>
__device__ __forceinline__ void gemm_phase(PG8_LAS unsigned char* lds, const Gemm g, const Sched& S, const Epi& E) {
    int tid_op = threadIdx.x; asm volatile("" : "+v"(tid_op));
    const int tid = tid_op, wid = __builtin_amdgcn_readfirstlane(tid >> 6), lane = tid & 63, wr = wid >> 2, wc = wid & 3, fr = lane & 15, fq = lane >> 4;
    const int K = g.K, nt = K / BK;
    unsigned voffA[2], voffB[2];
#pragma unroll
    for (int i = 0; i < 2; ++i) { int R, C; stage_rc(tid * 16 + i * 8192, R, C); const int Rb = Epi::PERM ? ((R & ~31) + perm32(R & 31)) : R;
        voffA[i] = (unsigned)(R * K + C) * 2u; voffB[i] = (unsigned)(Rb * K + C) * 2u; }
    const size_t kstep = (size_t)(BK * 2);
    const size_t hstep = (size_t)HALF * K * 2;
    const size_t tstep = 2 * hstep;
    const unsigned ldsw = (unsigned)wid * 1024u;
    const int aoff = lds_byte(wr * 64 + fr, fq * 8), boff = lds_byte(wc * 32 + fr, fq * 8);
#define PG8_SA(b, h) (((b) * 2 + (h)) * HTB)
#define PG8_SB(b, h) ((4 + (b) * 2 + (h)) * HTB)
#define PG8_STAGE(bufoff, gbase, voff) do { _Pragma("unroll") for (int _i = 0; _i < 2; ++_i) \
        __builtin_amdgcn_global_load_lds((const unsigned*)((const char*)(gbase) + (voff)[_i]), (PG8_LAS unsigned*)(lds + (bufoff) + ldsw + _i * 8192), 16, 0, 0); } while (0)
#define PG8_LDA(dst, b, h) do { _Pragma("unroll") for (int m = 0; m < 4; ++m) _Pragma("unroll") for (int k = 0; k < 2; ++k) dst[m][k] = *(const PG8_LAS bf16x8*)(lds + PG8_SA(b, h) + aoff + m * 2048 + k * 1024); } while (0)
#define PG8_LDB(dst, b, h) do { _Pragma("unroll") for (int n = 0; n < 2; ++n) _Pragma("unroll") for (int k = 0; k < 2; ++k) dst[n][k] = *(const PG8_LAS bf16x8*)(lds + PG8_SB(b, h) + boff + n * 2048 + k * 1024); } while (0)
#define PG8_MMA(ai, bj, At, Bt) do { __builtin_amdgcn_s_setprio(1); _Pragma("unroll") for (int m = 0; m < 4; ++m) _Pragma("unroll") for (int n = 0; n < 2; ++n) _Pragma("unroll") for (int k = 0; k < 2; ++k) \
        acc[ai][bj][m][n] = __builtin_amdgcn_mfma_f32_16x16x32_bf16(Bt[n][k], At[m][k], acc[ai][bj][m][n], 0, 0, 0); __builtin_amdgcn_s_setprio(0); } while (0)
#define PG8_WAIT_V(n) asm volatile("s_waitcnt vmcnt(" #n ")" ::: "memory")
#define PG8_WAIT_L(n) asm volatile("s_waitcnt lgkmcnt(" #n ")" ::: "memory")
#define PG8_BAR __builtin_amdgcn_s_barrier()
#define PG8_SCHED __builtin_amdgcn_sched_barrier(0)
    Unit cur, nxt; int ui = 0;
    if (!S.next(0, cur)) return;
    f32x4 acc[2][2][4][2];
#pragma unroll
    for (int a = 0; a < 2; ++a)
#pragma unroll
        for (int b = 0; b < 2; ++b)
#pragma unroll
            for (int m = 0; m < 4; ++m)
#pragma unroll
                for (int n = 0; n < 2; ++n) acc[a][b][m][n] = (f32x4){0.f, 0.f, 0.f, 0.f};
    bf16x8 At[4][2], B0[2][2], B1[2][2];
    const char* cA = (const char*)g.A + (size_t)cur.pm * tstep; const char* cB = (const char*)g.Bt + (size_t)cur.pn * tstep;
    S.a_ready(cur);
    if constexpr (SP2) {
        PG8_STAGE(PG8_SB(0, 0), cB, voffB); PG8_STAGE(PG8_SB(0, 1), cB + hstep, voffB); PG8_STAGE(PG8_SA(0, 0), cA, voffA); PG8_STAGE(PG8_SA(0, 1), cA + hstep, voffA);
        if (wr == 1) PG8_BAR;
        PG8_WAIT_V(2); PG8_BAR;
        PG8_STAGE(PG8_SB(1, 0), cB + kstep, voffB); PG8_STAGE(PG8_SA(1, 0), cA + kstep, voffA); PG8_STAGE(PG8_SB(1, 1), cB + hstep + kstep, voffB);
        PG8_WAIT_V(6); PG8_BAR;
    } else {
        PG8_STAGE(PG8_SB(0, 0), cB, voffB); PG8_STAGE(PG8_SA(0, 0), cA, voffA); PG8_STAGE(PG8_SB(0, 1), cB + hstep, voffB); PG8_STAGE(PG8_SA(0, 1), cA + hstep, voffA);
        if (wr == 1) PG8_BAR;
        PG8_WAIT_V(4); PG8_BAR;
        PG8_STAGE(PG8_SB(1, 0), cB + kstep, voffB); PG8_STAGE(PG8_SA(1, 0), cA + kstep, voffA); PG8_STAGE(PG8_SB(1, 1), cB + hstep + kstep, voffB);
        PG8_WAIT_V(6); PG8_BAR;
    }
    for (;;) {
        const bool has_next = S.next(ui + 1, nxt);
        const char* nA = has_next ? (const char*)g.A + (size_t)nxt.pm * tstep : cA; const char* nB = has_next ? (const char*)g.Bt + (size_t)nxt.pn * tstep : cB;
        for (int t = 0; t < nt; t += 2) {
            const bool last = (t == nt - 2);
            const char* a1 = cA + (size_t)(t + 1) * kstep;
            const char* a2 = last ? nA : cA + (size_t)(t + 2) * kstep; const char* b2 = last ? nB : cB + (size_t)(t + 2) * kstep;
            const char* a3 = a2 + kstep; const char* b3 = b2 + kstep;
            if (last && has_next) S.a_ready(nxt);
            if constexpr (SP2) {
            PG8_LDB(B0, 0, 0); PG8_LDB(B1, 0, 1); PG8_SCHED; PG8_LDA(At, 0, 0); PG8_STAGE(PG8_SA(1, 1), a1 + hstep, voffA);
            PG8_WAIT_V(8); PG8_WAIT_L(0); PG8_BAR; PG8_MMA(0, 0, At, B0); PG8_MMA(0, 1, At, B1); PG8_BAR; PG8_SCHED;
            PG8_LDA(At, 0, 1); PG8_STAGE(PG8_SB(0, 0), b2, voffB); PG8_STAGE(PG8_SB(0, 1), b2 + hstep, voffB); PG8_STAGE(PG8_SA(0, 0), a2, voffA);
            PG8_WAIT_V(8); PG8_WAIT_L(0); PG8_BAR; PG8_MMA(1, 0, At, B0); PG8_MMA(1, 1, At, B1); PG8_BAR; PG8_SCHED;
            PG8_LDB(B0, 1, 0); PG8_LDB(B1, 1, 1); PG8_SCHED; PG8_LDA(At, 1, 0); PG8_STAGE(PG8_SA(0, 1), a2 + hstep, voffA);
            PG8_WAIT_V(8); PG8_WAIT_L(0); PG8_BAR; PG8_MMA(0, 0, At, B0); PG8_MMA(0, 1, At, B1); PG8_BAR; PG8_SCHED;
            PG8_LDA(At, 1, 1); PG8_STAGE(PG8_SB(1, 0), b3, voffB); PG8_STAGE(PG8_SB(1, 1), b3 + hstep, voffB); PG8_STAGE(PG8_SA(1, 0), a3, voffA);
            PG8_WAIT_V(8); PG8_WAIT_L(0); PG8_BAR; PG8_MMA(1, 0, At, B0); PG8_MMA(1, 1, At, B1); PG8_BAR; PG8_SCHED;
            } else {
            PG8_LDB(B0, 0, 0); PG8_SCHED; PG8_LDA(At, 0, 0); PG8_STAGE(PG8_SA(1, 1), a1 + hstep, voffA);
            PG8_WAIT_L(8); PG8_BAR; PG8_WAIT_L(0); PG8_MMA(0, 0, At, B0); PG8_BAR; PG8_SCHED;
            PG8_LDB(B1, 0, 1); PG8_STAGE(PG8_SB(0, 0), b2, voffB);
            PG8_BAR; PG8_WAIT_L(0); PG8_MMA(0, 1, At, B1); PG8_BAR;
            PG8_LDA(At, 0, 1); PG8_STAGE(PG8_SA(0, 0), a2, voffA);
            PG8_BAR; PG8_WAIT_L(0); PG8_MMA(1, 0, At, B0); PG8_BAR; PG8_SCHED;
            PG8_STAGE(PG8_SB(0, 1), b2 + hstep, voffB);
            PG8_WAIT_V(6); PG8_BAR; PG8_MMA(1, 1, At, B1); PG8_BAR;
            PG8_LDB(B0, 1, 0); PG8_SCHED; PG8_LDA(At, 1, 0); PG8_STAGE(PG8_SA(0, 1), a2 + hstep, voffA);
            PG8_WAIT_L(8); PG8_BAR; PG8_WAIT_L(0); PG8_MMA(0, 0, At, B0); PG8_BAR; PG8_SCHED;
            PG8_LDB(B1, 1, 1); PG8_STAGE(PG8_SB(1, 0), b3, voffB);
            PG8_BAR; PG8_WAIT_L(0); PG8_MMA(0, 1, At, B1); PG8_BAR;
            PG8_LDA(At, 1, 1); PG8_STAGE(PG8_SA(1, 0), a3, voffA);
            PG8_BAR; PG8_WAIT_L(0); PG8_MMA(1, 0, At, B0); PG8_BAR; PG8_SCHED;
            PG8_STAGE(PG8_SB(1, 1), b3 + hstep, voffB);
            PG8_WAIT_V(6); PG8_BAR; PG8_MMA(1, 1, At, B1); PG8_BAR;
            }
        }
        if constexpr (ALIGN_EPI) { if (wr == 0) PG8_BAR; }
        if constexpr (!Epi::AFTER_DRAIN) { E(acc, cur, ui, wr, wc, fr, fq); S.done(cur); }
        if (!has_next) break;
#pragma unroll
        for (int a = 0; a < 2; ++a)
#pragma unroll
            for (int b = 0; b < 2; ++b)
#pragma unroll
                for (int m = 0; m < 4; ++m)
#pragma unroll
                    for (int n = 0; n < 2; ++n) acc[a][b][m][n] = (f32x4){0.f, 0.f, 0.f, 0.f};
        cur = nxt; cA = nA; cB = nB; ++ui;
        if constexpr (ALIGN_EPI) { if (wr == 1) PG8_BAR; }
    }
    PG8_WAIT_V(0);
    if constexpr (!ALIGN_EPI) { if (wr == 0) PG8_BAR; }
    PG8_BAR;
    if constexpr (Epi::AFTER_DRAIN) { E.fused(acc, cur, wr, wc, fr, fq, lds, wid, lane); S.done(cur); }
#undef PG8_SA
#undef PG8_SB
#undef PG8_STAGE
#undef PG8_LDA
#undef PG8_LDB
#undef PG8_MMA
#undef PG8_WAIT_V
#undef PG8_WAIT_L
#undef PG8_BAR
#undef PG8_SCHED
}
}

constexpr int D = 1024, NB = 8, SEQ = 2048, NMETA = 16, LSEQ = 2064, MP = NB * LSEQ, NS = 128, M = MP + NS;
constexpr int PW = 512, SW = 512, NIN = 3072, DFF = 2816, NUP = 5632, NG = 32, NST = 64, PHIST = 15;
constexpr int DEPTH = 2;
constexpr float RMS_EPS = 1e-6f;
static_assert(M % 256 == 0, "M");

constexpr size_t MiB = 1u << 20;
constexpr size_t WS_CTL = 0, CTL_ZERO_BYTES = 1 * MiB;
constexpr size_t WS_RS = 1 * MiB;
constexpr size_t WS_SM = 3 * MiB;
constexpr size_t WS_GTOP = 4 * MiB, WS_VTOP = WS_GTOP + 3 * MiB / 2, WS_GBOT = WS_VTOP + 3 * MiB / 2;
constexpr size_t WS_WIN = 9 * MiB, WS_WGLU = 15 * MiB, WS_WOUT = 17 * MiB, WS_WUP = 19 * MiB, WS_WDOWN = 30 * MiB, WS_WPOOL = WS_WDOWN + 11 * MiB / 2;
constexpr size_t WS_TWS = 36 * MiB, WS_TTOEP = 38 * MiB, WS_TWY = 42 * MiB;
constexpr size_t WS_X = 44 * MiB;
constexpr size_t WS_XB = 109 * MiB;
constexpr size_t WS_YS = WS_XB;
constexpr size_t WS_UP = WS_XB + 65 * MiB / 2;
constexpr size_t WS_US = WS_UP + 65 * MiB / 4;
constexpr size_t WS_GP = WS_US + 65 * MiB / 4;
constexpr size_t WS_GS = WS_GP + 65 * MiB / 2;
constexpr size_t WS_ACT = WS_UP;
constexpr size_t WS_END = WS_GS + 65 * MiB / 2;
static_assert(WS_ACT + (size_t)M * DFF * 2 <= WS_END, "act overlay");
static_assert(WS_GBOT + (size_t)65 * 2 * DFF * 4 <= WS_WIN, "edge buffers");
static_assert(WS_WPOOL + 4 * 256 * 128 * 2 <= WS_TWS, "weights");

constexpr int CW_BAR = 4096;

constexpr int LDS_BYTES = 163840;
constexpr int XCH_OFF = 131072;
constexpr int RSTD_OFF = XCH_OFF + 4096, RSTD_UNITS = 16;
constexpr int LDSCTL_OFF = LDS_BYTES - 256, MISC_OFF = LDSCTL_OFF;

#define GAS __attribute__((address_space(1)))
#define LAS __attribute__((address_space(3)))
typedef unsigned short bf16;
typedef unsigned v4u __attribute__((ext_vector_type(4)));
typedef unsigned v2u __attribute__((ext_vector_type(2)));
typedef float f32x4 __attribute__((ext_vector_type(4)));
typedef float f32x2 __attribute__((ext_vector_type(2)));
typedef short bf16x8 __attribute__((ext_vector_type(8)));
typedef GAS unsigned gu32;
#define LDS_WAIT() asm volatile("s_waitcnt lgkmcnt(0)" ::: "memory")
#define VM_WAIT() asm volatile("s_waitcnt vmcnt(0)" ::: "memory")
__device__ __forceinline__ unsigned f2bf(float f) { unsigned u = __builtin_bit_cast(unsigned, f); return (u + 0x7fffu + ((u >> 16) & 1u)) >> 16; }
__device__ __forceinline__ unsigned pk2(float lo, float hi) { return f2bf(lo) | (f2bf(hi) << 16); }
__device__ __forceinline__ float bflo(unsigned w) { return __builtin_bit_cast(float, w << 16); }
__device__ __forceinline__ float bfhi(unsigned w) { return __builtin_bit_cast(float, w & 0xffff0000u); }
__device__ __forceinline__ void unpack8(v4u w, float (&f)[8]) { f[0] = bflo(w.x); f[1] = bfhi(w.x); f[2] = bflo(w.y); f[3] = bfhi(w.y); f[4] = bflo(w.z); f[5] = bfhi(w.z); f[6] = bflo(w.w); f[7] = bfhi(w.w); }
__device__ __forceinline__ v4u pack8(const float (&f)[8]) { v4u w; w.x = pg8::cvt_pk_bf16(f[0], f[1]); w.y = pg8::cvt_pk_bf16(f[2], f[3]); w.z = pg8::cvt_pk_bf16(f[4], f[5]); w.w = pg8::cvt_pk_bf16(f[6], f[7]); return w; }
__device__ __forceinline__ unsigned cvt_pk_bf16_t(float lo, float hi) { unsigned r; asm volatile("s_nop 0\n\tv_cvt_pk_bf16_f32 %0, %1, %2" : "=v"(r) : "v"(lo), "v"(hi)); return r; }
__device__ __forceinline__ float wave_sum(float v) {
#pragma unroll
    for (int o = 1; o < 64; o <<= 1) v += __shfl_xor(v, o);
    return v;
}
__device__ __forceinline__ float sigm(float x) { return __builtin_amdgcn_rcpf(1.0f + __builtin_amdgcn_exp2f(-1.4426950409f * x)); }
__device__ __forceinline__ float gelu_t(float x) { const float t = x * (1.5957691216f + 0.0713548163f * x * x); return x * __builtin_amdgcn_rcpf(1.0f + __builtin_amdgcn_exp2f(-1.4426950409f * t)); }
__device__ __forceinline__ float rstd_of(const float* RS, int r) {
    const f32x4* p = (const f32x4*)(RS + (size_t)r * 16); const f32x4 a = p[0], b = p[1], c = p[2], d = p[3];
    const float s = (((a.x + a.y) + (a.z + a.w)) + ((b.x + b.y) + (b.z + b.w))) + (((c.x + c.y) + (c.z + c.w)) + ((d.x + d.y) + (d.z + d.w)));
    return 1.0f / sqrtf(s * (1.0f / D) + RMS_EPS);
}

template <class Sched> __device__ __forceinline__ void fill_rstd(LAS float* tab, const float* RS, const Sched& S, int tid) {
    pg8::Unit u;
    for (int i = 0; i < RSTD_UNITS && S.next(i, u); ++i) {
        const int row = tid >> 1, h = tid & 1; const f32x4* p = (const f32x4*)(RS + ((size_t)(u.pm * 256 + row)) * 16 + 8 * h); const f32x4 a = p[0], b = p[1];
        float s = ((a.x + a.y) + (a.z + a.w)) + ((b.x + b.y) + (b.z + b.w)); s += __shfl_xor(s, 1);
        if (h == 0) tab[i * 256 + row] = 1.0f / sqrtf(s * (1.0f / D) + RMS_EPS);
    }
    LDS_WAIT(); __syncthreads();
}

typedef f32x4 acc_t[2][2][4][2];

struct EpiIn {
    static constexpr bool PERM = true, AFTER_DRAIN = false;
    bf16 *UP, *US, *GP, *GS; const LAS float* rstd; float* pool_p; float* pool_s;
    __device__ __forceinline__ void operator()(acc_t& acc, const pg8::Unit& u, int ui, int wr, int wc, int fr_, int fq_) const {
        int fr = fr_, fq = fq_; asm volatile("" : "+v"(fr), "+v"(fq));
        const int colt = u.pn * 256 + wc * 32 + 8 * fq;
#pragma unroll
        for (int ai = 0; ai < 2; ++ai)
#pragma unroll
            for (int m = 0; m < 4; ++m) {
                const int r = u.pm * 256 + ai * 128 + wr * 64 + m * 16 + fr;
                const float rs = rstd[ui * 256 + ai * 128 + wr * 64 + m * 16 + fr];
#pragma unroll
                for (int bj = 0; bj < 2; ++bj) {
                    const int c0 = colt + 128 * bj;
                    f32x4 v0 = acc[ai][bj][m][0] * rs, v1 = acc[ai][bj][m][1] * rs;
                    if (u.pn < 2) {
                        v4u w; w.x = pg8::cvt_pk_bf16(v0[0], v0[1]); w.y = pg8::cvt_pk_bf16(v0[2], v0[3]); w.z = pg8::cvt_pk_bf16(v1[0], v1[1]); w.w = pg8::cvt_pk_bf16(v1[2], v1[3]);
                        *(v4u*)(UP + (size_t)r * PW + c0) = w;
                        if (r < MP) { const int b = r / LSEQ, t = r - b * LSEQ;
                            if (t >= LSEQ - PHIST) { float* p = pool_p + ((size_t)(b * PHIST + (t - (LSEQ - PHIST)))) * PW + c0; *(f32x4*)p = v0; *(f32x4*)(p + 4) = v1; } }
                        else { float* p = pool_s + ((size_t)((r - MP) * PHIST + (PHIST - 1))) * PW + c0; *(f32x4*)p = v0; *(f32x4*)(p + 4) = v1; }
                    } else if (u.pn < 4) {
                        v4u w; w.x = pg8::cvt_pk_bf16(v0[0], v0[1]); w.y = pg8::cvt_pk_bf16(v0[2], v0[3]); w.z = pg8::cvt_pk_bf16(v1[0], v1[1]); w.w = pg8::cvt_pk_bf16(v1[2], v1[3]);
                        *(v4u*)(US + (size_t)r * SW + (c0 - 512)) = w;
                    } else {
#pragma unroll
                        for (int j = 0; j < 4; ++j) { v0[j] = sigm(v0[j]); v1[j] = sigm(v1[j]); }
                        v4u w; w.x = cvt_pk_bf16_t(v0[0], v0[1]); w.y = cvt_pk_bf16_t(v0[2], v0[3]); w.z = cvt_pk_bf16_t(v1[0], v1[1]); w.w = cvt_pk_bf16_t(v1[2], v1[3]);
                        if (u.pn < 8) *(v4u*)(GP + (size_t)r * D + (c0 - 1024)) = w; else *(v4u*)(GS + (size_t)r * D + (c0 - 2048)) = w;
                    }
                }
                asm volatile("" ::: "memory");
            }
    }
};

struct EpiGlu {
    static constexpr bool PERM = true, AFTER_DRAIN = false;
    bf16* GP; const bf16* GS;
    __device__ __forceinline__ void operator()(acc_t& acc, const pg8::Unit& u, int ui, int wr, int wc, int fr_, int fq_) const {
        int fr = fr_, fq = fq_; asm volatile("" : "+v"(fr), "+v"(fq));
        const int c0 = u.pn * 128 + wc * 32 + 8 * fq;
#pragma unroll
        for (int ai = 0; ai < 2; ++ai)
#pragma unroll
            for (int m = 0; m < 4; ++m) {
                const int r = u.pm * 256 + ai * 128 + wr * 64 + m * 16 + fr;
                bf16* pp = GP + (size_t)r * D + c0;
                float pv[8], gv[8], o[8];
                unpack8(*(const v4u*)pp, pv); unpack8(*(const v4u*)(GS + (size_t)r * D + c0), gv);
#pragma unroll
                for (int n = 0; n < 2; ++n)
#pragma unroll
                    for (int j = 0; j < 4; ++j) o[4 * n + j] = pv[4 * n + j] + gv[4 * n + j] * acc[ai][0][m][n][j] * sigm(acc[ai][1][m][n][j]);
#ifndef NO_GLU_STORE
                *(v4u*)pp = pack8(o);
#else
                asm volatile("" :: "v"(o[0]), "v"(o[1]), "v"(o[2]), "v"(o[3]), "v"(o[4]), "v"(o[5]), "v"(o[6]), "v"(o[7]));
#endif
                asm volatile("" ::: "memory");
            }
    }
};

struct EpiRes {
    static constexpr bool PERM = true, AFTER_DRAIN = false;
    float* X; bf16* XB; float* RS;
    __device__ __forceinline__ void operator()(acc_t& acc, const pg8::Unit& u, int ui, int wr, int wc, int fr_, int fq_) const {
        int fr = fr_, fq = fq_; asm volatile("" : "+v"(fr), "+v"(fq));
        const int colt = u.pn * 256 + wc * 32 + 8 * fq;
#pragma unroll
        for (int ai = 0; ai < 2; ++ai)
#pragma unroll
            for (int m = 0; m < 4; ++m) {
                const int r = u.pm * 256 + ai * 128 + wr * 64 + m * 16 + fr;
                float ss = 0.f;
#pragma unroll
                for (int bj = 0; bj < 2; ++bj) {
                    const int c0 = colt + 128 * bj;
                    float* xp = X + (size_t)r * D + c0;
#ifdef NO_RMW
                    f32x4 x0 = acc[ai][bj][m][0], x1 = acc[ai][bj][m][1];
#else
                    f32x4 x0 = *(const f32x4*)xp + acc[ai][bj][m][0], x1 = *(const f32x4*)(xp + 4) + acc[ai][bj][m][1];
#endif
                    *(f32x4*)xp = x0; *(f32x4*)(xp + 4) = x1;
                    v4u w; w.x = pg8::cvt_pk_bf16(x0[0], x0[1]); w.y = pg8::cvt_pk_bf16(x0[2], x0[3]); w.z = pg8::cvt_pk_bf16(x1[0], x1[1]); w.w = pg8::cvt_pk_bf16(x1[2], x1[3]);
#ifndef NO_XB_WRITE
                    *(v4u*)(XB + (size_t)r * D + c0) = w;
#else
                    asm volatile("" :: "v"(w.x), "v"(w.y), "v"(w.z), "v"(w.w));
#endif
                    ss += ((x0[0] * x0[0] + x0[1] * x0[1]) + (x0[2] * x0[2] + x0[3] * x0[3])) + ((x1[0] * x1[0] + x1[1] * x1[1]) + (x1[2] * x1[2] + x1[3] * x1[3]));
                }
                ss += __shfl_xor(ss, 16); ss += __shfl_xor(ss, 32);
                if (fq == 0) RS[(size_t)r * 16 + u.pn * 4 + wc] = ss;
                asm volatile("" ::: "memory");
            }
    }
};

struct EpiUp {
    static constexpr bool PERM = true, AFTER_DRAIN = false;
    bf16* ACT; const LAS float* rstd; const float* cw; const float* cb; const float* sconv; float* conv_p; float* conv_s; float* Gtop; float* Vtop; float* Gbot; LAS float* xch;
    __device__ __forceinline__ void operator()(acc_t& acc, const pg8::Unit& u, int ui, int wr, int wc, int fr_, int fq_) const {
        int fr = fr_, fq = fq_; asm volatile("" : "+v"(fr), "+v"(fq));
        const int lane = fr + 16 * fq;
        const int gc0 = 128 * u.pn + 32 * wc + 8 * fq;
        const int r0 = u.pm * 256;
#pragma unroll
        for (int ai = 0; ai < 2; ++ai)
#pragma unroll
            for (int m = 0; m < 4; ++m) {
                const float rs = rstd[ui * 256 + ai * 128 + wr * 64 + m * 16 + fr];
#pragma unroll
                for (int bj = 0; bj < 2; ++bj) { acc[ai][bj][m][0] *= rs; acc[ai][bj][m][1] *= rs; }
            }
#pragma unroll
        for (int ai = 0; ai < 2; ++ai)
            if (fr >= 14) { LAS float* p = xch + ((((ai * 2 + wr) * 4 + wc) * 2 + (fr - 14)) * 4 + fq) * 8; *(LAS f32x4*)p = acc[ai][0][3][0]; *(LAS f32x4*)(p + 4) = acc[ai][0][3][1]; }
        if (wr == 1 && fr >= 14) { float* p = Gbot + ((size_t)(u.pm * 2 + fr - 14)) * DFF + gc0; *(f32x4*)p = acc[1][0][3][0]; *(f32x4*)(p + 4) = acc[1][0][3][1]; }
        if (wr == 0 && fr < 2) { const size_t o = ((size_t)(u.pm * 2 + fr)) * DFF + gc0;
            *(f32x4*)(Gtop + o) = acc[0][0][0][0]; *(f32x4*)(Gtop + o + 4) = acc[0][0][0][1]; *(f32x4*)(Vtop + o) = acc[0][1][0][0]; *(f32x4*)(Vtop + o + 4) = acc[0][1][0][1]; }
        asm volatile("s_waitcnt lgkmcnt(0)" ::: "memory"); __builtin_amdgcn_s_barrier(); asm volatile("" ::: "memory");
        f32x4 w0[2], w1[2], w2[2], bb[2];
#pragma unroll
        for (int n = 0; n < 2; ++n) { w0[n] = *(const f32x4*)(cw + gc0 + 4 * n); w1[n] = *(const f32x4*)(cw + DFF + gc0 + 4 * n); w2[n] = *(const f32x4*)(cw + 2 * DFF + gc0 + 4 * n); bb[n] = *(const f32x4*)(cb + gc0 + 4 * n); }
        const int src1 = (lane & 48) | ((fr + 15) & 15), src2 = (lane & 48) | ((fr + 14) & 15);
#pragma unroll
        for (int ai = 0; ai < 2; ++ai) {
            f32x4 P1[2], P2[2];
            if (wr == 1 || ai == 1) {
                const int sai = (wr == 1) ? ai : 0, swr = (wr == 1) ? 0 : 1;
                const LAS float* p = xch + ((((sai * 2 + swr) * 4 + wc) * 2 + 0) * 4 + fq) * 8;
#pragma unroll
                for (int n = 0; n < 2; ++n) { const f32x4 e2 = *(const LAS f32x4*)(p + 4 * n), e1 = *(const LAS f32x4*)(p + 32 + 4 * n); P1[n] = e1; P2[n] = (fr == 0) ? e2 : e1; }
            } else { P1[0] = P1[1] = P2[0] = P2[1] = (f32x4){0.f, 0.f, 0.f, 0.f}; }
#pragma unroll
            for (int m = 0; m < 4; ++m) {
                const int r = r0 + ai * 128 + wr * 64 + m * 16 + fr;
                f32x4 R1[2], R2[2], g1[2], g2[2];
#pragma unroll
                for (int n = 0; n < 2; ++n)
#pragma unroll
                    for (int j = 0; j < 4; ++j) { const float cur = acc[ai][0][m][n][j]; R1[n][j] = __shfl(cur, src1); R2[n][j] = __shfl(cur, src2);
                        g1[n][j] = (fr >= 1) ? R1[n][j] : P1[n][j]; g2[n][j] = (fr >= 2) ? R2[n][j] : P2[n][j]; }
                if (r < MP) {
                    const int b = r / LSEQ, t = r - b * LSEQ;
                    if (t == 0) { g1[0] = g1[1] = (f32x4){0.f, 0.f, 0.f, 0.f}; }
                    if (t <= 1) { g2[0] = g2[1] = (f32x4){0.f, 0.f, 0.f, 0.f}; }
                    if (t >= LSEQ - 2) { float* p = conv_p + ((size_t)(b * 2 + (t - (LSEQ - 2)))) * DFF + gc0; *(f32x4*)p = acc[ai][0][m][0]; *(f32x4*)(p + 4) = acc[ai][0][m][1]; }
                } else {
                    const int bs = r - MP; const float* h = sconv + ((size_t)bs * 2) * DFF + gc0;
                    g2[0] = *(const f32x4*)h; g2[1] = *(const f32x4*)(h + 4); g1[0] = *(const f32x4*)(h + DFF); g1[1] = *(const f32x4*)(h + DFF + 4);
                    float* p = conv_s + ((size_t)(bs * 2 + 1)) * DFF + gc0; *(f32x4*)p = acc[ai][0][m][0]; *(f32x4*)(p + 4) = acc[ai][0][m][1];
                }
                float o[8];
#pragma unroll
                for (int n = 0; n < 2; ++n)
#pragma unroll
                    for (int j = 0; j < 4; ++j) { const float c = bb[n][j] + w0[n][j] * g2[n][j] + w1[n][j] * g1[n][j] + w2[n][j] * acc[ai][0][m][n][j]; o[4 * n + j] = gelu_t(c) * acc[ai][1][m][n][j]; }
                *(v4u*)(ACT + (size_t)r * DFF + gc0) = pack8(o);
                P1[0] = R1[0]; P1[1] = R1[1]; P2[0] = R2[0]; P2[1] = R2[1];
                asm volatile("" ::: "memory");
            }
        }
    }
};
#define XB_TMO      128
#define XB_XCNT(j)  (256  + 64 * (j))
#define XB_XSUB(j)  (1280 + 64 * (j))
#define XB_XGEN(j)  (2304 + 64 * (j))
#define XB_TOP      3328
#define XB_TOPGEN   3392
#define XCD_BAR_WORDS 3456
#define XB_SPIN_CAP (1u << 18)

__device__ __forceinline__ unsigned xb_ld(unsigned* p)              { return __hip_atomic_load(p, __ATOMIC_RELAXED, __HIP_MEMORY_SCOPE_AGENT); }
__device__ __forceinline__ unsigned xb_add(unsigned* p, unsigned v) { return __hip_atomic_fetch_add(p, v, __ATOMIC_RELAXED, __HIP_MEMORY_SCOPE_AGENT); }
__device__ __forceinline__ unsigned xb_xcc_id() { return (unsigned)__builtin_amdgcn_s_getreg((3 << 11) | 20) & 0xFu; }
#define XB_SPIN(cond, bar) do { unsigned _sp = 0; while (cond) { __builtin_amdgcn_s_sleep(1); \
    if ((++_sp & 255u) == 0u) { if (xb_ld(&(bar)[XB_TMO])) break; if (_sp > XB_SPIN_CAP) { atomicAdd(&(bar)[XB_TMO], 1u); break; } } } } while (0)

struct XcdBarrier {
    unsigned* bar; unsigned x;
    volatile LAS unsigned* st;
};

__device__ __forceinline__ XcdBarrier xcd_barrier_post(unsigned* bar, volatile LAS unsigned* st) {
    XcdBarrier b; b.bar = bar; b.x = xb_xcc_id(); b.st = st;
    if (threadIdx.x == 0) (void)xb_add(&bar[XB_XCNT(b.x)], 1u);
    return b;
}
__device__ __forceinline__ void xcd_barrier_complete(unsigned* bar, unsigned x, unsigned& nloc, unsigned& nx) {
    const unsigned G = gridDim.x * gridDim.y * gridDim.z;
    unsigned sum, cnt, mine, sp = 0u;
    for (;;) {
        sum = 0u; cnt = 0u; mine = 0u;
#pragma unroll
        for (unsigned j = 0; j < 16; ++j) { const unsigned c = xb_ld(&bar[XB_XCNT(j)]); sum += c; cnt += (c > 0u) ? 1u : 0u; mine = (j == x) ? c : mine; }
        if (sum == G) break;
        __builtin_amdgcn_s_sleep(1);
        if ((++sp & 255u) == 0u) { if (xb_ld(&bar[XB_TMO])) break; if (sp > XB_SPIN_CAP) { atomicAdd(&bar[XB_TMO], 1u); break; } }
    }
    nloc = mine > 0u ? mine : 1u; nx = cnt > 0u ? cnt : 1u;
}

__device__ __forceinline__ void xcd_barrier(const XcdBarrier& b) {
    asm volatile("s_waitcnt vmcnt(0)" ::: "memory");
    __syncthreads();
    if (threadIdx.x == 0) {
        unsigned* bar = b.bar;
        __builtin_amdgcn_s_waitcnt(0);
        unsigned nloc = b.st[0], nx = b.st[1];
        if (nloc == 0u) { xcd_barrier_complete(bar, b.x, nloc, nx); b.st[0] = nloc; b.st[1] = nx; }
        const unsigned old = xb_add(&bar[XB_XSUB(b.x)], 1u);
        const unsigned gen = old / nloc;
        if (old + 1u == (gen + 1u) * nloc) {
            __builtin_amdgcn_fence(__ATOMIC_RELEASE, "agent");
            asm volatile("s_waitcnt vmcnt(0)" ::: "memory");
            const unsigned og = xb_add(&bar[XB_TOP], 1u);
            const unsigned tg = og / nx;
            if (og + 1u == (tg + 1u) * nx) xb_add(&bar[XB_TOPGEN], 1u);
            else XB_SPIN(xb_ld(&bar[XB_TOPGEN]) == tg, bar);
            __builtin_amdgcn_fence(__ATOMIC_ACQUIRE, "agent");
            xb_add(&bar[XB_XGEN(b.x)], 1u);
            asm volatile("s_waitcnt vmcnt(0)" ::: "memory");
        } else {
            XB_SPIN(xb_ld(&bar[XB_XGEN(b.x)]) == gen, bar);
            __builtin_amdgcn_fence(__ATOMIC_ACQUIRE, "agent");
            asm volatile("s_waitcnt vmcnt(0)" ::: "memory");
        }
    }
    __syncthreads();
}

__device__ __forceinline__ void transpose_item(const float* W, int K, int N, bf16* WT, LAS float* scr, int item, int lane, const float* rs, const float* cs, int mode) {
    const int nblk = N / 32, kb = item / nblk, nb = item % nblk, k0 = 64 * kb, n0 = 32 * nb;
    const float csv = cs ? cs[n0 + (lane & 31)] : 1.0f;
#pragma unroll 8
    for (int i = 0; i < 32; ++i) { const int kk = 2 * i + (lane >> 5); float w = W[(size_t)(k0 + kk) * N + n0 + (lane & 31)]; if (rs) w *= rs[k0 + kk]; scr[kk * 33 + (lane & 31)] = w * csv; }
    LDS_WAIT(); asm volatile("" ::: "memory");
    int drow0 = n0;
    if (mode == 1) { const int half = N / 2; const int v = n0 < half ? n0 : n0 - half; drow0 = 256 * (v / 128) + (n0 < half ? 0 : 128) + (v % 128); }
    const int c = lane & 7;
#pragma unroll
    for (int j = 0; j < 4; ++j) { const int n = (lane >> 3) + 8 * j; const LAS float* s = scr + (8 * c) * 33 + n;
        v4u o; o.x = pk2(s[0 * 33], s[1 * 33]); o.y = pk2(s[2 * 33], s[3 * 33]); o.z = pk2(s[4 * 33], s[5 * 33]); o.w = pk2(s[6 * 33], s[7 * 33]);
        *(v4u*)(WT + (size_t)(drow0 + n) * K + k0 + 8 * c) = o; }
    LDS_WAIT(); asm volatile("" ::: "memory");
}

__device__ __forceinline__ void sincos_f(float x, float& s, float& c) {
    const float kf = rintf(x * 0.6366197724f);
    const float y = ((x - kf * 1.5703125f) - kf * 4.837512969970703125e-4f) - kf * 7.54978995489188216e-8f;
    const int k = (int)kf;
    const float y2 = y * y;
    const float sp = y * (1.0f + y2 * (-1.6666667163e-1f + y2 * (8.3333337680e-3f + y2 * (-1.9841270114e-4f + y2 * (2.7557314297e-6f + y2 * -2.5050759689e-8f)))));
    const float cp = 1.0f + y2 * (-0.5f + y2 * (4.1666667908e-2f + y2 * (-1.3888889225e-3f + y2 * (2.4801587642e-5f + y2 * (-2.7557314297e-7f + y2 * 2.0876755880e-9f)))));
    const int q = k & 3;
    s = (q == 0) ? sp : (q == 1) ? cp : (q == 2) ? -sp : -cp;
    c = (q == 0) ? cp : (q == 1) ? -sp : (q == 2) ? -cp : sp;
}

__device__ __forceinline__ void ssm_tables(LAS unsigned char* lds, int tid, int l, int g, int part,
        const float* A_re, const float* A_im, const float* log_dt, const float* B_re, const float* B_im, const float* C_re, const float* C_im, const float* Dsk,
        bf16* TWS, bf16* TTOEP, bf16* TWY, float* SMT) {
    LAS f32x2* Pk = (LAS f32x2*)lds;
    LAS f32x2* Bb = Pk + 17 * 64;
    LAS f32x2* Cc = Bb + 64 * 16;
    LAS float* Mt = (LAS float*)(Cc + 16 * 64);
    __syncthreads();
    const int lg = l * NG + g;
    if (tid < 64) {
        const int n = tid;
        const float dt = expf(log_dt[lg]);
        const float lr = A_re[lg * 64 + n], li = A_im[lg * 64 + n];
        const float mag = expf(lr * dt); float sn, cs; sincos_f(li * dt, sn, cs);
        const float ar = mag * cs, ai = mag * sn, den = lr * lr + li * li, nr = ar - 1.0f, ni = ai;
        const float qr = (nr * lr + ni * li) / den, qi = (ni * lr - nr * li) / den;
        float pr = 1.0f, pi = 0.0f;
        for (int k = 0; k <= 16; ++k) { Pk[k * 64 + n] = (f32x2){pr, pi}; const float t = pr * ar - pi * ai; pi = pr * ai + pi * ar; pr = t; }
        if (part == 0) { float* o = SMT + ((size_t)lg * 64 + n) * 8; const f32x2 p16 = Pk[16 * 64 + n];
            *(f32x4*)o = (f32x4){ar, ai, qr, qi}; *(f32x4*)(o + 4) = (f32x4){p16.x, p16.y, 0.f, 0.f}; }
        for (int qc = 0; qc < 16; ++qc) { const float br = B_re[((size_t)lg * 64 + n) * 16 + qc], bi = B_im[((size_t)lg * 64 + n) * 16 + qc];
            Bb[n * 16 + qc] = (f32x2){qr * br - qi * bi, qr * bi + qi * br}; }
    }
    for (int i = tid; i < 1024; i += 512) Cc[i] = (f32x2){C_re[(size_t)lg * 1024 + i], C_im[(size_t)lg * 1024 + i]};
    LDS_WAIT(); __syncthreads();
    for (int e = tid; e < 4096; e += 512) {
        const int tau = e >> 8, p = (e >> 4) & 15, qc = e & 15; float s = 0.f;
        for (int n = 0; n < 64; ++n) { const f32x2 c = Cc[p * 64 + n], pk = Pk[tau * 64 + n], b = Bb[n * 16 + qc];
            const float cpr = c.x * pk.x - c.y * pk.y, cpi = c.x * pk.y + c.y * pk.x; s += cpr * b.x - cpi * b.y; }
        if (tau == 0 && p == qc) s += Dsk[l * SW + 16 * g + p];
        Mt[e] = s;
    }
    LDS_WAIT(); __syncthreads();
    for (int it = tid; it < 1024; it += 512) {
        const int row = 32 * part + (it >> 5), oct = it & 31, j = row >> 4, p = row & 15, i_ = oct >> 1, q0 = (oct & 1) * 8;
        float v[8];
#pragma unroll
        for (int e = 0; e < 8; ++e) v[e] = (i_ <= j) ? Mt[(j - i_) * 256 + p * 16 + q0 + e] : 0.f;
        v4u o; o.x = pk2(v[0], v[1]); o.y = pk2(v[2], v[3]); o.z = pk2(v[4], v[5]); o.w = pk2(v[6], v[7]);
        *(v4u*)(TTOEP + ((size_t)(g * 256 + row)) * 256 + 8 * oct) = o;
    }
    {
        const int s = 16 * part + (tid >> 5), oct = tid & 31, n = s & 63, i_ = oct >> 1, q0 = (oct & 1) * 8;
        float v[8];
#pragma unroll
        for (int e = 0; e < 8; ++e) { const f32x2 pk = Pk[(15 - i_) * 64 + n], b = Bb[n * 16 + q0 + e]; v[e] = (s < 64) ? (pk.x * b.x - pk.y * b.y) : (pk.x * b.y + pk.y * b.x); }
        v4u o; o.x = pk2(v[0], v[1]); o.y = pk2(v[2], v[3]); o.z = pk2(v[4], v[5]); o.w = pk2(v[6], v[7]);
        *(v4u*)(TWS + ((size_t)(g * 128 + s)) * 256 + 8 * oct) = o;
    }
    {
        const int row = 32 * part + (tid >> 4), oct = tid & 15, j = row >> 4, p = row & 15;
        float v[8];
#pragma unroll
        for (int e = 0; e < 8; ++e) { const int si = 8 * oct + e, n = si & 63; const f32x2 c = Cc[p * 64 + n], pk = Pk[(j + 1) * 64 + n];
            v[e] = (si < 64) ? (c.x * pk.x - c.y * pk.y) : -(c.x * pk.y + c.y * pk.x); }
        v4u o; o.x = pk2(v[0], v[1]); o.y = pk2(v[2], v[3]); o.z = pk2(v[4], v[5]); o.w = pk2(v[6], v[7]);
        *(v4u*)(TWY + ((size_t)(g * 256 + row)) * 128 + 8 * oct) = o;
    }
}

constexpr int UPITCH = 528;
constexpr int SSM_U_BYTES = 144 * UPITCH;
__device__ __forceinline__ void ssm_unit(LAS unsigned char* lds, int tid, int l, int b, int g, const bf16* US, bf16* YS,
        const bf16* TWS, const bf16* TTOEP, const bf16* TWY, const float* SMT, float* re_p, float* im_p) {
    const int wid = __builtin_amdgcn_readfirstlane(tid >> 6), lane = tid & 63, fr = lane & 15, fq = lane >> 4;
    LAS unsigned char* Ul = lds;
    LAS unsigned char* SHl = lds + SSM_U_BYTES + UPITCH;
    __syncthreads();
    for (int p = tid; p < LSEQ * 2; p += 512) { const int tok = p >> 1, half = p & 1;
        const v4u v = *(const v4u*)(US + ((size_t)(b * LSEQ + tok)) * SW + 16 * g + 8 * half);
        *(LAS v4u*)(Ul + (tok >> 4) * UPITCH + (tok & 15) * 32 + half * 16) = v; }
    for (int p = tid; p < 15 * 32; p += 512) *(LAS v4u*)(Ul + (129 + (p >> 5)) * UPITCH + (p & 31) * 16) = (v4u){0u, 0u, 0u, 0u};
    if (tid < 16) *(LAS v4u*)(SHl - UPITCH + tid * 16) = (v4u){0u, 0u, 0u, 0u};
    LDS_WAIT(); __syncthreads();
    {
        bf16x8 Bf[8];
#pragma unroll
        for (int ks = 0; ks < 8; ++ks) Bf[ks] = *(const bf16x8*)(TWS + ((size_t)(g * 128 + 16 * wid + fr)) * 256 + 32 * ks + 8 * fq);
        for (int mt = 0; mt < 9; ++mt) {
            f32x4 a = {0.f, 0.f, 0.f, 0.f};
#pragma unroll
            for (int ks = 0; ks < 8; ++ks) { const bf16x8 uf = *(const LAS bf16x8*)(Ul + (16 * mt + fr) * UPITCH + (32 * ks + 8 * fq) * 2); a = __builtin_amdgcn_mfma_f32_16x16x32_bf16(Bf[ks], uf, a, 0, 0, 0); }
            *(LAS f32x4*)(SHl + (16 * mt + fr) * UPITCH + (16 * wid + 4 * fq) * 4) = a;
        }
    }
    LDS_WAIT(); __syncthreads();
    if (wid == 0) {
        const int n = lane; const f32x4 sm = *(const f32x4*)(SMT + ((size_t)(l * NG + g) * 64 + n) * 8 + 4);
        const float a16r = sm.x, a16i = sm.y; float hr = 0.f, hi = 0.f;
        for (int c = 0; c < 129; ++c) {
            const float sr = *(const LAS float*)(SHl + c * UPITCH + n * 4), si = *(const LAS float*)(SHl + c * UPITCH + (64 + n) * 4);
            const float nr = a16r * hr - a16i * hi + sr, ni = a16r * hi + a16i * hr + si; hr = nr; hi = ni;
            *(LAS unsigned short*)(SHl + c * UPITCH + n * 2) = (unsigned short)f2bf(hr);
            *(LAS unsigned short*)(SHl + c * UPITCH + (64 + n) * 2) = (unsigned short)f2bf(hi);
        }
        re_p[((size_t)(b * NG + g)) * 64 + n] = hr; im_p[((size_t)(b * NG + g)) * 64 + n] = hi;
    }
    LDS_WAIT(); __syncthreads();
    {
        bf16x8 Bt[2][8], By[2][4];
#pragma unroll
        for (int jj = 0; jj < 2; ++jj) { const size_t row = (size_t)(g * 256 + 16 * (2 * wid + jj) + fr);
#pragma unroll
            for (int ks = 0; ks < 8; ++ks) Bt[jj][ks] = *(const bf16x8*)(TTOEP + row * 256 + 32 * ks + 8 * fq);
#pragma unroll
            for (int ks = 0; ks < 4; ++ks) By[jj][ks] = *(const bf16x8*)(TWY + row * 128 + 32 * ks + 8 * fq); }
        for (int mt = 0; mt < 9; ++mt) {
            f32x4 a0 = {0.f, 0.f, 0.f, 0.f}, a1 = {0.f, 0.f, 0.f, 0.f};
#pragma unroll
            for (int ks = 0; ks < 8; ++ks) { const bf16x8 uf = *(const LAS bf16x8*)(Ul + (16 * mt + fr) * UPITCH + (32 * ks + 8 * fq) * 2);
                a0 = __builtin_amdgcn_mfma_f32_16x16x32_bf16(Bt[0][ks], uf, a0, 0, 0, 0); a1 = __builtin_amdgcn_mfma_f32_16x16x32_bf16(Bt[1][ks], uf, a1, 0, 0, 0); }
#pragma unroll
            for (int ks = 0; ks < 4; ++ks) { const bf16x8 hf = *(const LAS bf16x8*)(SHl - UPITCH + (16 * mt + fr) * UPITCH + (32 * ks + 8 * fq) * 2);
                a0 = __builtin_amdgcn_mfma_f32_16x16x32_bf16(By[0][ks], hf, a0, 0, 0, 0); a1 = __builtin_amdgcn_mfma_f32_16x16x32_bf16(By[1][ks], hf, a1, 0, 0, 0); }
            const int c = 16 * mt + fr;
            if (c < 129) {
                const size_t row = (size_t)(b * LSEQ + 16 * c + 2 * wid);
                v2u o0, o1; o0.x = pg8::cvt_pk_bf16(gelu_t(a0[0]), gelu_t(a0[1])); o0.y = pg8::cvt_pk_bf16(gelu_t(a0[2]), gelu_t(a0[3]));
                o1.x = pg8::cvt_pk_bf16(gelu_t(a1[0]), gelu_t(a1[1])); o1.y = pg8::cvt_pk_bf16(gelu_t(a1[2]), gelu_t(a1[3]));
                *(v2u*)(YS + row * SW + 16 * g + 4 * fq) = o0; *(v2u*)(YS + (row + 1) * SW + 16 * g + 4 * fq) = o1;
            }
        }
    }
}

__device__ __forceinline__ void ssm_sample_item(int lane, int l, int bs, int g, const bf16* US, bf16* YS, const float* SMT,
        const float* B_re, const float* B_im, const float* C_re, const float* C_im, const float* Dsk, const float* st_re, const float* st_im, float* re_s, float* im_s) {
    const int n = lane, lg = l * NG + g;
    const f32x4 sm = *(const f32x4*)(SMT + ((size_t)lg * 64 + n) * 8);
    float uu[16];
    { float t8[8]; const bf16* up = US + ((size_t)(MP + bs)) * SW + 16 * g; unpack8(*(const v4u*)up, t8);
#pragma unroll
      for (int e = 0; e < 8; ++e) uu[e] = t8[e];
      unpack8(*(const v4u*)(up + 8), t8);
#pragma unroll
      for (int e = 0; e < 8; ++e) uu[8 + e] = t8[e]; }
    float sr = 0.f, si = 0.f;
    const float* br = B_re + ((size_t)lg * 64 + n) * 16; const float* bi = B_im + ((size_t)lg * 64 + n) * 16;
#pragma unroll
    for (int q4 = 0; q4 < 4; ++q4) { const f32x4 a = *(const f32x4*)(br + 4 * q4), c = *(const f32x4*)(bi + 4 * q4);
#pragma unroll
        for (int j = 0; j < 4; ++j) { sr += a[j] * uu[4 * q4 + j]; si += c[j] * uu[4 * q4 + j]; } }
    const size_t so = ((size_t)((l * NS + bs) * NG + g)) * 64 + n;
    const float h0r = st_re[so], h0i = st_im[so];
    const float hr = sm.x * h0r - sm.y * h0i + (sm.z * sr - sm.w * si), hi = sm.x * h0i + sm.y * h0r + (sm.z * si + sm.w * sr);
    re_s[so] = hr; im_s[so] = hi;
    float ymine = 0.f;
#pragma unroll
    for (int p = 0; p < 16; ++p) { const float v = wave_sum(C_re[((size_t)lg * 16 + p) * 64 + n] * hr - C_im[((size_t)lg * 16 + p) * 64 + n] * hi); ymine = (lane == p) ? v : ymine; }
    if (lane < 16) { float uself = 0.f;
#pragma unroll
        for (int p = 0; p < 16; ++p) uself = (lane == p) ? uu[p] : uself;
        const float y = ymine + Dsk[l * SW + 16 * g + lane] * uself;
        YS[((size_t)(MP + bs)) * SW + 16 * g + lane] = (bf16)f2bf(gelu_t(y)); }
}

constexpr int PPITCH = 272;
__device__ __forceinline__ void pool_unit(LAS unsigned char* lds, int tid, int pm, int grp, const bf16* UP, bf16* GP, const bf16* WPOOL, const float* spool) {
    const int wid = __builtin_amdgcn_readfirstlane(tid >> 6), lane = tid & 63, wr = wid >> 2, wc = wid & 3, fr = lane & 15, fq = lane >> 4;
    LAS unsigned char* Ut = lds; LAS unsigned char* Dt = lds + 73728;
    const int r0 = pm * 256, w = 2 << grp;
    __syncthreads();
    for (int it = tid; it < 271 * 16; it += 512) { const int rr = it >> 4, oct = it & 15, r = r0 - 15 + rr; v4u v = {0u, 0u, 0u, 0u};
        if (r >= 0) v = *(const v4u*)(UP + (size_t)r * PW + 128 * grp + 8 * oct);
        *(LAS v4u*)(Ut + rr * PPITCH + oct * 16) = v; }
    LDS_WAIT(); __syncthreads();
    for (int it = tid; it < 4096; it += 512) {
        const int row = it >> 4, oct = it & 15, r = r0 + row;
        float self[8], sum[8], x[8]; float inv;
        unpack8(*(const LAS v4u*)(Ut + (row + 15) * PPITCH + oct * 16), self);
#pragma unroll
        for (int e = 0; e < 8; ++e) sum[e] = self[e];
        if (r < MP) { const int t = r % LSEQ; const int nav = (t + 1 < w) ? (t + 1) : w;
            for (int i = 1; i < nav; ++i) { unpack8(*(const LAS v4u*)(Ut + (row + 15 - i) * PPITCH + oct * 16), x);
#pragma unroll
                for (int e = 0; e < 8; ++e) sum[e] += x[e]; }
            inv = 1.0f / (float)nav;
        } else { const int bs = r - MP;
            for (int i = 1; i < w; ++i) { const float* h = spool + ((size_t)(bs * PHIST + PHIST - i)) * PW + 128 * grp + 8 * oct; const f32x4 a = *(const f32x4*)h, c = *(const f32x4*)(h + 4);
#pragma unroll
                for (int e = 0; e < 4; ++e) { sum[e] += a[e]; sum[4 + e] += c[e]; } }
            inv = 1.0f / (float)w;
        }
#pragma unroll
        for (int e = 0; e < 8; ++e) x[e] = sum[e] * inv - self[e];
        *(LAS v4u*)(Dt + row * PPITCH + oct * 16) = pack8(x);
    }
    LDS_WAIT(); __syncthreads();
    bf16x8 Bf[2][2][4];
#pragma unroll
    for (int bj = 0; bj < 2; ++bj)
#pragma unroll
        for (int n = 0; n < 2; ++n) { const int prow = 128 * bj + 32 * wc + 8 * (fr >> 2) + 4 * n + (fr & 3);
#pragma unroll
            for (int ks = 0; ks < 4; ++ks) Bf[bj][n][ks] = *(const bf16x8*)(WPOOL + ((size_t)(grp * 256 + prow)) * 128 + 32 * ks + 8 * fq); }
#pragma unroll
    for (int ai = 0; ai < 2; ++ai)
#pragma unroll
        for (int m = 0; m < 4; ++m) {
            f32x4 a[2][2];
#pragma unroll
            for (int bj = 0; bj < 2; ++bj)
#pragma unroll
                for (int n = 0; n < 2; ++n) a[bj][n] = (f32x4){0.f, 0.f, 0.f, 0.f};
            const int row = 128 * ai + 64 * wr + 16 * m + fr;
#pragma unroll
            for (int ks = 0; ks < 4; ++ks) { const bf16x8 df = *(const LAS bf16x8*)(Dt + row * PPITCH + (32 * ks + 8 * fq) * 2);
#pragma unroll
                for (int bj = 0; bj < 2; ++bj)
#pragma unroll
                    for (int n = 0; n < 2; ++n) a[bj][n] = __builtin_amdgcn_mfma_f32_16x16x32_bf16(Bf[bj][n][ks], df, a[bj][n], 0, 0, 0); }
            const int r = r0 + row;
#pragma unroll
            for (int bj = 0; bj < 2; ++bj) { bf16* p = GP + (size_t)r * D + 256 * grp + 128 * bj + 32 * wc + 8 * fq; float gv[8], o[8]; unpack8(*(const v4u*)p, gv);
#pragma unroll
                for (int n = 0; n < 2; ++n)
#pragma unroll
                    for (int j = 0; j < 4; ++j) o[4 * n + j] = gv[4 * n + j] * a[bj][n][j];
                *(v4u*)p = pack8(o); }
        }
}

__device__ __forceinline__ void act_fixup(int tid, int pm, bf16* ACT, const float* cw, const float* cb, const float* Gtop, const float* Vtop, const float* Gbot) {
    for (int it = tid; it < 2 * (DFF / 4); it += 512) {
        const int e = it / (DFF / 4), c4 = (it % (DFF / 4)) * 4, r = pm * 256 + e, t = r % LSEQ;
        const f32x4 g0 = *(const f32x4*)(Gtop + ((size_t)(pm * 2 + e)) * DFF + c4), vv = *(const f32x4*)(Vtop + ((size_t)(pm * 2 + e)) * DFF + c4);
        const f32x4 b1 = *(const f32x4*)(Gbot + ((size_t)((pm - 1) * 2 + 1)) * DFF + c4), b0 = *(const f32x4*)(Gbot + ((size_t)((pm - 1) * 2 + 0)) * DFF + c4), t0 = *(const f32x4*)(Gtop + ((size_t)(pm * 2)) * DFF + c4);
        f32x4 g1 = (e == 1) ? t0 : b1, g2 = (e == 1) ? b1 : b0;
        if (t == 0) g1 = (f32x4){0.f, 0.f, 0.f, 0.f};
        if (t <= 1) g2 = (f32x4){0.f, 0.f, 0.f, 0.f};
        const f32x4 w0 = *(const f32x4*)(cw + c4), w1 = *(const f32x4*)(cw + DFF + c4), w2 = *(const f32x4*)(cw + 2 * DFF + c4), bb = *(const f32x4*)(cb + c4);
        float o[4];
#pragma unroll
        for (int j = 0; j < 4; ++j) o[j] = gelu_t(bb[j] + w0[j] * g2[j] + w1[j] * g1[j] + w2[j] * g0[j]) * vv[j];
        v2u w; w.x = pg8::cvt_pk_bf16(o[0], o[1]); w.y = pg8::cvt_pk_bf16(o[2], o[3]);
        *(v2u*)(ACT + (size_t)r * DFF + c4) = w;
    }
}

constexpr size_t O_YP = 0, O_YS = O_YP + (size_t)NB * SEQ * D, O_POOLP = O_YS + (size_t)NS * D, O_REP = O_POOLP + (size_t)DEPTH * NB * PHIST * PW,
                 O_IMP = O_REP + (size_t)DEPTH * NB * NG * NST, O_CONVP = O_IMP + (size_t)DEPTH * NB * NG * NST, O_POOLS = O_CONVP + (size_t)DEPTH * NB * 2 * DFF,
                 O_RES = O_POOLS + (size_t)DEPTH * NS * PHIST * PW, O_IMS = O_RES + (size_t)DEPTH * NS * NG * NST, O_CONVS = O_IMS + (size_t)DEPTH * NS * NG * NST,
                 O_END = O_CONVS + (size_t)DEPTH * NS * 2 * DFF;
static_assert(O_END == 21643264, "output size");

enum { I_XP = 0, I_XS, I_SPOOL, I_SRE, I_SIM, I_SCONV, I_META, I_N1G, I_WIN, I_POOLW, I_POOLSC, I_ARE, I_AIM, I_LOGDT, I_BRE, I_BIM, I_CRE, I_CIM, I_DSK, I_WGLU, I_WOUT, I_N2G, I_WUP, I_CONVW, I_CONVB, I_WDOWN, I_NFG, N_IN };

struct Args { const float* in[N_IN]; float* out; unsigned char* ws; unsigned long long pad; };

constexpr int NWAVES = 8;
__global__ void __launch_bounds__(NWAVES * 64, 2) mk_fwd(Args args) {
    extern __shared__ __attribute__((aligned(16))) unsigned char lds_raw[];
    LAS unsigned char* lds = (LAS unsigned char*)lds_raw;
    volatile LAS unsigned* MISC = (volatile LAS unsigned*)(lds + MISC_OFF);
    const int tid = threadIdx.x, lane = tid & 63, wave = __builtin_amdgcn_readfirstlane(tid >> 6);
    const int G = gridDim.x, bx = blockIdx.x;
    unsigned char* ws = args.ws; float* out = args.out;
    for (int u = tid; u < (LDS_BYTES - LDSCTL_OFF) / 4; u += NWAVES * 64) ((LAS unsigned*)(lds + LDSCTL_OFF))[u] = 0u;
    __syncthreads();
    XcdBarrier bar = xcd_barrier_post((unsigned*)(ws + WS_CTL) + CW_BAR, MISC + 8);
#ifdef BAR_DELAY
#define GRID_BAR() do { xcd_barrier(bar); { const unsigned long long t0_ = __builtin_amdgcn_s_memrealtime(); while (__builtin_amdgcn_s_memrealtime() - t0_ < BAR_DELAY) __builtin_amdgcn_s_sleep(8); } __syncthreads(); } while (0)
#else
#define GRID_BAR() xcd_barrier(bar)
#endif
#define OPAQUE_TID() int ptid = threadIdx.x; asm volatile("" : "+v"(ptid)); const int plane = ptid & 63; (void)plane

    float* RS = (float*)(ws + WS_RS); float* SMT = (float*)(ws + WS_SM);
    float* Gtop = (float*)(ws + WS_GTOP); float* Vtop = (float*)(ws + WS_VTOP); float* Gbot = (float*)(ws + WS_GBOT);
    bf16* WIN = (bf16*)(ws + WS_WIN); bf16* WGLU = (bf16*)(ws + WS_WGLU); bf16* WOUT = (bf16*)(ws + WS_WOUT); bf16* WUP = (bf16*)(ws + WS_WUP); bf16* WDOWN = (bf16*)(ws + WS_WDOWN); bf16* WPOOL = (bf16*)(ws + WS_WPOOL);
    bf16* TWS = (bf16*)(ws + WS_TWS); bf16* TTOEP = (bf16*)(ws + WS_TTOEP); bf16* TWY = (bf16*)(ws + WS_TWY);
    float* X = (float*)(ws + WS_X); bf16* XB = (bf16*)(ws + WS_XB); bf16* YSB = (bf16*)(ws + WS_YS);
    bf16* UPB = (bf16*)(ws + WS_UP); bf16* USB = (bf16*)(ws + WS_US); bf16* GP = (bf16*)(ws + WS_GP); bf16* GS = (bf16*)(ws + WS_GS); bf16* ACT = (bf16*)(ws + WS_ACT);
    const int gw = bx * NWAVES + wave, NGW = G * NWAVES;

#ifndef PH_MASK
#define PH_MASK 0xFFFF
#endif
#define PH(k) ((PH_MASK >> (k)) & 1)
    if (PH(0)) {
    OPAQUE_TID(); const int pgw = bx * NWAVES + __builtin_amdgcn_readfirstlane(ptid >> 6);
    for (int m = pgw; m < M; m += NGW) {
        const float* src;
        if (m < MP) { const int b = m / LSEQ, t = m - b * LSEQ; src = (t < NMETA) ? args.in[I_META] + (size_t)t * D : args.in[I_XP] + ((size_t)(b * SEQ + t - NMETA)) * D; }
        else src = args.in[I_XS] + (size_t)(m - MP) * D;
        const f32x4* s4 = (const f32x4*)src + plane; f32x4 v[4]; float ss = 0.f;
#pragma unroll
        for (int j = 0; j < 4; ++j) { v[j] = s4[64 * j]; ss += (v[j].x * v[j].x + v[j].y * v[j].y) + (v[j].z * v[j].z + v[j].w * v[j].w); }
        ss = wave_sum(ss);
        f32x4* x4 = (f32x4*)(X + (size_t)m * D) + plane; unsigned long long* o8 = (unsigned long long*)(XB + (size_t)m * D) + plane;
#pragma unroll
        for (int j = 0; j < 4; ++j) { x4[64 * j] = v[j]; o8[64 * j] = (unsigned long long)pk2(v[j].x, v[j].y) | ((unsigned long long)pk2(v[j].z, v[j].w) << 32); }
        if (plane < 16) RS[(size_t)m * 16 + plane] = (plane == 0) ? ss : 0.f;
    }
    {
        const int gt = bx * (NWAVES * 64) + ptid, NGT = G * NWAVES * 64;
        for (int i = gt; i < DEPTH * NS * 14 * (PW / 4); i += NGT) { const int lb = i / (14 * (PW / 4)), rem = i % (14 * (PW / 4)), rr = rem / (PW / 4), c4 = rem % (PW / 4);
            *(f32x4*)(out + O_POOLS + ((size_t)(lb * PHIST + rr)) * PW + 4 * c4) = *(const f32x4*)(args.in[I_SPOOL] + ((size_t)(lb * PHIST + rr + 1)) * PW + 4 * c4); }
        for (int i = gt; i < DEPTH * NS * (DFF / 4); i += NGT) { const int lb = i / (DFF / 4), c4 = i % (DFF / 4);
            *(f32x4*)(out + O_CONVS + ((size_t)(lb * 2)) * DFF + 4 * c4) = *(const f32x4*)(args.in[I_SCONV] + ((size_t)(lb * 2 + 1)) * DFF + 4 * c4); }
    }

    }
#pragma unroll 1
    for (int l = 0; l < DEPTH; ++l) {
        if (PH(1))
        {
            OPAQUE_TID();
            LAS float* scr = (LAS float*)(lds + wave * 16384);
            constexpr int I_IN = (D / 64) * (NIN / 32), I_GLU = (SW / 64) * (2 * D / 32), I_OUT = (D / 64) * (D / 32), I_UP = (D / 64) * (NUP / 32), I_DOWN = (DFF / 64) * (D / 32), I_PL = (128 / 64) * (256 / 32);
            constexpr int NITEMS = I_IN + I_GLU + I_OUT + I_UP + I_DOWN + 4 * I_PL;
            for (int it = gw; it < NITEMS; it += NGW) {
                int r = it;
                if (r < I_IN) { transpose_item(args.in[I_WIN] + (size_t)l * D * NIN, D, NIN, WIN, scr, r, plane, args.in[I_N1G] + l * D, nullptr, 0); continue; } r -= I_IN;
                if (r < I_GLU) { transpose_item(args.in[I_WGLU] + (size_t)l * SW * 2 * D, SW, 2 * D, WGLU, scr, r, plane, nullptr, nullptr, 1); continue; } r -= I_GLU;
                if (r < I_OUT) { transpose_item(args.in[I_WOUT] + (size_t)l * D * D, D, D, WOUT, scr, r, plane, nullptr, nullptr, 0); continue; } r -= I_OUT;
                if (r < I_UP) { transpose_item(args.in[I_WUP] + (size_t)l * D * NUP, D, NUP, WUP, scr, r, plane, args.in[I_N2G] + l * D, nullptr, 1); continue; } r -= I_UP;
                if (r < I_DOWN) { transpose_item(args.in[I_WDOWN] + (size_t)l * DFF * D, DFF, D, WDOWN, scr, r, plane, nullptr, nullptr, 0); continue; } r -= I_DOWN;
                { const int grp = r / I_PL; transpose_item(args.in[I_POOLW] + ((size_t)(l * 4 + grp)) * 128 * 256, 128, 256, WPOOL + (size_t)grp * 256 * 128, scr, r % I_PL, plane, nullptr, args.in[I_POOLSC] + l * D + 256 * grp, 0); }
            }
            for (int u = bx; u < NG * 8; u += G)
                ssm_tables(lds, ptid, l, u >> 3, u & 7, args.in[I_ARE], args.in[I_AIM], args.in[I_LOGDT], args.in[I_BRE], args.in[I_BIM], args.in[I_CRE], args.in[I_CIM], args.in[I_DSK], TWS, TTOEP, TWY, SMT);
        }
        GRID_BAR();

        if (PH(2))
        {
            pg8::Gemm g{XB, WIN, M, NIN, D}; pg8::StaticOrder S; S.init(M, NIN, G, bx);
            { OPAQUE_TID(); fill_rstd((LAS float*)(lds + RSTD_OFF), RS, S, ptid); }
            EpiIn E{UPB, USB, GP, GS, (const LAS float*)(lds + RSTD_OFF), out + O_POOLP + (size_t)l * NB * PHIST * PW, out + O_POOLS + (size_t)l * NS * PHIST * PW};
            pg8::gemm_phase<EpiIn, pg8::StaticOrder, true, true>(lds, g, S, E);
        }
        GRID_BAR();

        if (PH(3))
        {
            OPAQUE_TID();
            for (int u = bx; u < NB * NG; u += G)
                ssm_unit(lds, ptid, l, u >> 5, u & 31, USB, YSB, TWS, TTOEP, TWY, SMT, out + O_REP + (size_t)l * NB * NG * NST, out + O_IMP + (size_t)l * NB * NG * NST);
            for (int it = gw; it < NS * NG; it += NGW)
                ssm_sample_item(plane, l, it >> 5, it & 31, USB, YSB, SMT, args.in[I_BRE], args.in[I_BIM], args.in[I_CRE], args.in[I_CIM], args.in[I_DSK], args.in[I_SRE], args.in[I_SIM], out + O_RES, out + O_IMS);
            for (int u = bx; u < (M / 256) * 4; u += G)
                pool_unit(lds, ptid, u >> 2, u & 3, UPB, GP, WPOOL, args.in[I_SPOOL] + (size_t)l * NS * PHIST * PW);
        }
        GRID_BAR();

        if (PH(4))
        {
            pg8::Gemm g{YSB, WGLU, M, 2 * D, SW}; pg8::StaticOrder S; S.init(M, 2 * D, G, bx);
            EpiGlu E{GP, GS};
            pg8::gemm_phase<EpiGlu, pg8::StaticOrder, true, true>(lds, g, S, E);
        }
        GRID_BAR();

        if (PH(5))
        {
#ifdef D_FROM_XB
            pg8::Gemm g{D_FROM_XB, WOUT, M, D, D}; pg8::StaticOrder S; S.init(M, D, G, bx);
#else
            pg8::Gemm g{GP, WOUT, M, D, D}; pg8::StaticOrder S; S.init(M, D, G, bx);
#endif
            EpiRes E{X, XB, RS};
            pg8::gemm_phase<EpiRes, pg8::StaticOrder, true, true>(lds, g, S, E);
        }
        GRID_BAR();

        if (PH(6))
        {
            pg8::Gemm g{XB, WUP, M, NUP, D}; pg8::StaticOrder S; S.init(M, NUP, G, bx);
            { OPAQUE_TID(); fill_rstd((LAS float*)(lds + RSTD_OFF), RS, S, ptid); }
            EpiUp E{ACT, (const LAS float*)(lds + RSTD_OFF), args.in[I_CONVW] + (size_t)l * 3 * DFF, args.in[I_CONVB] + (size_t)l * DFF, args.in[I_SCONV] + (size_t)l * NS * 2 * DFF,
                    out + O_CONVP + (size_t)l * NB * 2 * DFF, out + O_CONVS + (size_t)l * NS * 2 * DFF, Gtop, Vtop, Gbot, (LAS float*)(lds + XCH_OFF)};
            pg8::gemm_phase<EpiUp, pg8::StaticOrder, true, true>(lds, g, S, E);
        }
        GRID_BAR();

        if (PH(7))
        {
            pg8::Gemm g{ACT, WDOWN, M, D, DFF}; pg8::StaticOrder S; S.init(M, D, G, bx);
            { OPAQUE_TID(); pg8::Unit u; for (int i = 0; S.next(i, u); ++i) if (u.pm >= 1) act_fixup(ptid, u.pm, ACT, args.in[I_CONVW] + (size_t)l * 3 * DFF, args.in[I_CONVB] + (size_t)l * DFF, Gtop, Vtop, Gbot); }
            VM_WAIT(); __syncthreads();
            EpiRes E{X, XB, RS};
            pg8::gemm_phase<EpiRes, pg8::StaticOrder, true, true>(lds, g, S, E);
        }
        GRID_BAR();
    }

#ifdef TMO_CHECK
    {
        const unsigned tmo = __hip_atomic_load((unsigned*)(ws + WS_CTL) + CW_BAR + XB_TMO, __ATOMIC_RELAXED, __HIP_MEMORY_SCOPE_AGENT);
        const unsigned nz = __hip_atomic_load((unsigned*)(ws + WS_CTL) + 8, __ATOMIC_RELAXED, __HIP_MEMORY_SCOPE_AGENT);
        if (tmo != 0u || nz != 0u) { const float val = (nz != 0u) ? 1.0e6f : 1.0e3f; for (int i = bx * 512 + threadIdx.x; i < NS * D; i += G * 512) out[O_YS + i] = val; return; }
    }
#endif
    if (PH(8))
    {
    OPAQUE_TID(); const int pgw = bx * NWAVES + __builtin_amdgcn_readfirstlane(ptid >> 6);
    for (int m = pgw; m < M; m += NGW) {
        float* dst;
        if (m < MP) { const int b = m / LSEQ, t = m - b * LSEQ; if (t < NMETA) continue; dst = out + O_YP + ((size_t)(b * SEQ + t - NMETA)) * D; }
        else dst = out + O_YS + (size_t)(m - MP) * D;
        const f32x4* s4 = (const f32x4*)(X + (size_t)m * D) + plane; f32x4 v[4]; float ss = 0.f;
#pragma unroll
        for (int j = 0; j < 4; ++j) { v[j] = s4[64 * j]; ss += (v[j].x * v[j].x + v[j].y * v[j].y) + (v[j].z * v[j].z + v[j].w * v[j].w); }
        const float rstd = 1.0f / sqrtf(wave_sum(ss) * (1.0f / D) + RMS_EPS);
        const f32x4* g4 = (const f32x4*)args.in[I_NFG] + plane; f32x4* d4 = (f32x4*)dst + plane;
#pragma unroll
        for (int j = 0; j < 4; ++j) d4[64 * j] = v[j] * rstd * g4[64 * j];
    }
    }
}

extern "C" void kernel_launch(void* const* d_in, const int* in_sizes, int n_in, void* d_out, int out_size, void* d_ws, size_t ws_size, hipStream_t stream) {
    static int grid = 0;
    if (grid == 0) {
        if (n_in != N_IN || (size_t)out_size != O_END || ws_size < WS_END) { fprintf(stderr, "kernel_launch: unexpected shapes: n_in %d out %d ws %zu\n", n_in, out_size, ws_size); grid = -1; return; }
        int dev = 0, cus = 0, per_cu = 0;
        if (hipGetDevice(&dev) != hipSuccess || hipDeviceGetAttribute(&cus, hipDeviceAttributeMultiprocessorCount, dev) != hipSuccess) { grid = -1; return; }
        if (hipFuncSetAttribute((const void*)mk_fwd, hipFuncAttributeMaxDynamicSharedMemorySize, LDS_BYTES) != hipSuccess) { fprintf(stderr, "kernel_launch: hipFuncSetAttribute failed\n"); grid = -1; return; }
        if (hipOccupancyMaxActiveBlocksPerMultiprocessor(&per_cu, (const void*)mk_fwd, NWAVES * 64, LDS_BYTES) != hipSuccess || per_cu < 1) { fprintf(stderr, "kernel_launch: occupancy query says %d blocks per CU\n", per_cu); }
        (void)hipGetLastError();
        grid = cus;
    }
    if (grid < 0) return;
    if (hipMemsetAsync((char*)d_ws + WS_CTL, 0, CTL_ZERO_BYTES, stream) != hipSuccess) { fprintf(stderr, "kernel_launch: memset failed\n"); return; }
    Args a{};
    for (int i = 0; i < N_IN; ++i) a.in[i] = (const float*)d_in[i];
    a.out = (float*)d_out; a.ws = (unsigned char*)d_ws; a.pad = 0ull;
    hipLaunchKernelGGL(mk_fwd, dim3(grid), dim3(NWAVES * 64), LDS_BYTES, stream, a);
    const hipError_t le = hipPeekAtLastError();
    if (le != hipSuccess) fprintf(stderr, "kernel_launch: launch failed: %s\n", hipGetErrorName(le));
}
```

```cpp
#include <hip/hip_runtime.h>
#include <cstdio>
#include <cstdint>
namespace pg8 {
#define PG8_LAS __attribute__((address_space(3)))
typedef unsigned short bf16_t;
typedef short bf16x8 __attribute__((ext_vector_type(8)));
typedef float f32x4 __attribute__((ext_vector_type(4)));
typedef unsigned u32x4 __attribute__((ext_vector_type(4)));
constexpr int BM = 256, BK = 64, HALF = 128, HTB = HALF * BK * 2  , STAGE_BYTES = 8 * HTB, NXCD = 8, WGM = 8;

__host__ __device__ __forceinline__ int lds_byte(int r, int c) { const int st = (r >> 4) * 2 + (c >> 5), rr = r & 15, cc = c & 31, ob = rr * 64 + cc * 2; return st * 1024 + (ob ^ (((ob >> 9) & 1) << 5)); }
__host__ __device__ __forceinline__ void stage_rc(int b, int& R, int& C) { const int st = b / 1024, sb = b % 1024, swz = sb ^ (((sb >> 9) & 1) << 5); R = (st >> 1) * 16 + swz / 64; C = (st & 1) * 32 + (swz % 64) / 2; }
__host__ __device__ __forceinline__ int perm32(int rho) { const int n = rho >> 4, i = rho & 15; return 8 * (i >> 2) + 4 * n + (i & 3); }

struct Unit { int pm, pn; };
struct Gemm { const bf16_t* A; const bf16_t* Bt; int M, N, K; };

struct StaticOrder {
    int nM, nN, nwg, G, c;
    __host__ __device__ __forceinline__ void init(int M, int N, int G_, int c_) { nM = M / BM; nN = N / BM; nwg = nM * nN; G = G_; c = c_; }
    __host__ __device__ __forceinline__ bool next(int i, Unit& u) const {
        const int L = i * G + c; if (L >= nwg) return false;
        int wgid = L; { const int q = nwg / NXCD, r = nwg % NXCD, xcd = wgid % NXCD, off = wgid / NXCD; wgid = (xcd < r ? xcd * (q + 1) : r * (q + 1) + (xcd - r) * q) + off; }
        const int nig = WGM * nN, gid = wgid / nig, fm = gid * WGM, gsz = (nM - fm) < WGM ? (nM - fm) : WGM;
        u.pm = fm + ((wgid % nig) % gsz); u.pn = (wgid % nig) / gsz; return true;
    }
    int strip_base = -1;
    __host__ __device__ __forceinline__ int strip_rows(const Unit& u) const { return (strip_base >= 0 && (u.pm & 3) == ((u.pn + (u.pn >> 2)) & 3)) ? strip_base + 16 * (u.pm >> 2) : -1; }
    __device__ __forceinline__ void a_ready(const Unit&) const {}
    __device__ __forceinline__ void done(const Unit&) const {}
};

__device__ __forceinline__ unsigned cvt_pk_bf16(float lo, float hi) { unsigned r; asm volatile("v_cvt_pk_bf16_f32 %0, %1, %2" : "=v"(r) : "v"(lo), "v"(hi)); return r; }
constexpr int XS_BYTES = 2048;
template <class Epi, class Sched, bool STRIP>
__device__ __forceinline__ void gemm_phase(PG8_LAS unsigned char* lds, PG8_LAS unsigned char* xs  , const Gemm g, const Sched& S, const Epi& E) {
    int tid_op = threadIdx.x; asm volatile("" : "+v"(tid_op));
    const int tid = tid_op, wid = __builtin_amdgcn_readfirstlane(tid >> 6), lane = tid & 63, wr = wid >> 2, wc = wid & 3, fr = lane & 15, fq = lane >> 4;
    const int K = g.K, nt = K / BK;
    unsigned voffA[2], voffB[2];
#pragma unroll
    for (int i = 0; i < 2; ++i) { int R, C; stage_rc(tid * 16 + i * 8192, R, C); const int Rb = Epi::PERM ? ((R & ~31) + perm32(R & 31)) : R;
        voffA[i] = (unsigned)(R * K + C) * 2u; voffB[i] = (unsigned)(Rb * K + C) * 2u; }
    const bool xw = wid < 2;
    const int xR = 8 * (wid & 1) + (lane >> 3); const unsigned voffX = (unsigned)(xR * K + 8 * ((lane & 7) ^ (xR & 7))) * 2u;
    const int xoff0 = fr * 128 + ((fq ^ (fr & 7)) * 16), xoff1 = fr * 128 + (((4 + fq) ^ (fr & 7)) * 16);
    const size_t kstep = (size_t)(BK * 2), hstep = (size_t)HALF * K * 2, tstep = 2 * hstep;
    const unsigned ldsw = (unsigned)wid * 1024u;
    const int aoff = lds_byte(wr * 64 + fr, fq * 8), boff = lds_byte(wc * 32 + fr, fq * 8);
#define PG8_SA(b, h) (((b) * 2 + (h)) * HTB)
#define PG8_SB(b, h) ((4 + (b) * 2 + (h)) * HTB)
#define PG8_STAGE(bufoff, gbase, voff) do { _Pragma("unroll") for (int _i = 0; _i < 2; ++_i) \
        __builtin_amdgcn_global_load_lds((const unsigned*)((const char*)(gbase) + (voff)[_i]), (PG8_LAS unsigned*)(lds + (bufoff) + ldsw + _i * 8192), 16, 0, 0); } while (0)
#define PG8_STAGEX(b, gbase) do { if constexpr (STRIP) { if (xw) \
        __builtin_amdgcn_global_load_lds((const unsigned*)((const char*)(gbase) + voffX), (PG8_LAS unsigned*)(xs + (b) * XS_BYTES + wid * 1024), 16, 0, 0); } } while (0)
#define PG8_LDA(dst, b, h) do { _Pragma("unroll") for (int m = 0; m < 4; ++m) _Pragma("unroll") for (int k = 0; k < 2; ++k) dst[m][k] = *(const PG8_LAS bf16x8*)(lds + PG8_SA(b, h) + aoff + m * 2048 + k * 1024); } while (0)
#define PG8_LDB(dst, b, h) do { _Pragma("unroll") for (int n = 0; n < 2; ++n) _Pragma("unroll") for (int k = 0; k < 2; ++k) dst[n][k] = *(const PG8_LAS bf16x8*)(lds + PG8_SB(b, h) + boff + n * 2048 + k * 1024); } while (0)
#define PG8_LDX(b) do { if constexpr (STRIP) if (cstrip >= 0) { Ax[0] = *(const PG8_LAS bf16x8*)(xs + (b) * XS_BYTES + xoff0); Ax[1] = *(const PG8_LAS bf16x8*)(xs + (b) * XS_BYTES + xoff1); } } while (0)
#define PG8_MMA(ai, bj, At, Bt) do { __builtin_amdgcn_s_setprio(1); _Pragma("unroll") for (int m = 0; m < 4; ++m) _Pragma("unroll") for (int n = 0; n < 2; ++n) _Pragma("unroll") for (int k = 0; k < 2; ++k) \
        acc[ai][bj][m][n] = __builtin_amdgcn_mfma_f32_16x16x32_bf16(Bt[n][k], At[m][k], acc[ai][bj][m][n], 0, 0, 0); __builtin_amdgcn_s_setprio(0); } while (0)
#define PG8_MMAX() do { if constexpr (STRIP) { if (cstrip >= 0) { \
        if (wr == 0) { _Pragma("unroll") for (int k = 0; k < 2; ++k) { accX[0] = __builtin_amdgcn_mfma_f32_16x16x32_bf16(B0[0][k], Ax[k], accX[0], 0, 0, 0); accX[1] = __builtin_amdgcn_mfma_f32_16x16x32_bf16(B1[0][k], Ax[k], accX[1], 0, 0, 0); } } \
        else         { _Pragma("unroll") for (int k = 0; k < 2; ++k) { accX[0] = __builtin_amdgcn_mfma_f32_16x16x32_bf16(B0[1][k], Ax[k], accX[0], 0, 0, 0); accX[1] = __builtin_amdgcn_mfma_f32_16x16x32_bf16(B1[1][k], Ax[k], accX[1], 0, 0, 0); } } } } } while (0)
#define PG8_WAIT_V(n) asm volatile("s_waitcnt vmcnt(" #n ")" ::: "memory")
#define PG8_WAIT_VL() do { if constexpr (STRIP) { if (xw) PG8_WAIT_V(9); else PG8_WAIT_V(8); } else PG8_WAIT_V(8); } while (0)
#define PG8_WAIT_L(n) asm volatile("s_waitcnt lgkmcnt(" #n ")" ::: "memory")
#define PG8_BAR __builtin_amdgcn_s_barrier()
#define PG8_SCHED __builtin_amdgcn_sched_barrier(0)
    Unit cur, nxt; int ui = 0;
    if (!S.next(0, cur)) return;
    f32x4 acc[2][2][4][2];
#pragma unroll
    for (int a = 0; a < 2; ++a)
#pragma unroll
        for (int b = 0; b < 2; ++b)
#pragma unroll
            for (int m = 0; m < 4; ++m)
#pragma unroll
                for (int n = 0; n < 2; ++n) acc[a][b][m][n] = (f32x4){0.f, 0.f, 0.f, 0.f};
    f32x4 accX[2] = {{0.f, 0.f, 0.f, 0.f}, {0.f, 0.f, 0.f, 0.f}};
    bf16x8 At[4][2], B0[2][2], B1[2][2], Ax[2];
    Ax[0] = (bf16x8){0, 0, 0, 0, 0, 0, 0, 0}; Ax[1] = Ax[0];
    const char* cA = (const char*)g.A + (size_t)cur.pm * tstep; const char* cB = (const char*)g.Bt + (size_t)cur.pn * tstep;
    int cstrip = STRIP ? S.strip_rows(cur) : -1;
    const char* cX = (cstrip >= 0) ? (const char*)g.A + (size_t)cstrip * K * 2 : cA;
    S.a_ready(cur);
    PG8_STAGE(PG8_SB(0, 0), cB, voffB); PG8_STAGE(PG8_SB(0, 1), cB + hstep, voffB); PG8_STAGE(PG8_SA(0, 0), cA, voffA); PG8_STAGEX(0, cX); PG8_STAGE(PG8_SA(0, 1), cA + hstep, voffA);
    if (wr == 1) PG8_BAR;
    PG8_WAIT_V(2); PG8_BAR;
    PG8_STAGE(PG8_SB(1, 0), cB + kstep, voffB); PG8_STAGE(PG8_SA(1, 0), cA + kstep, voffA); PG8_STAGE(PG8_SB(1, 1), cB + hstep + kstep, voffB); PG8_STAGEX(1, cX + kstep);
    if constexpr (STRIP) { if (xw) PG8_WAIT_V(7); else PG8_WAIT_V(6); } else PG8_WAIT_V(6);
    PG8_BAR;
    for (;;) {
        const bool has_next = S.next(ui + 1, nxt);
        const char* nA = has_next ? (const char*)g.A + (size_t)nxt.pm * tstep : cA; const char* nB = has_next ? (const char*)g.Bt + (size_t)nxt.pn * tstep : cB;
        const int nstrip = (STRIP && has_next) ? S.strip_rows(nxt) : -1;
        const char* nX = has_next ? ((nstrip >= 0) ? (const char*)g.A + (size_t)nstrip * K * 2 : nA) : cX;
        for (int t = 0; t < nt; t += 2) {
            const bool last = (t == nt - 2);
            const char* a1 = cA + (size_t)(t + 1) * kstep;
            const char* a2 = last ? nA : cA + (size_t)(t + 2) * kstep; const char* b2 = last ? nB : cB + (size_t)(t + 2) * kstep; const char* x2 = last ? nX : cX + (size_t)(t + 2) * kstep;
            const char* a3 = a2 + kstep; const char* b3 = b2 + kstep; const char* x3 = x2 + kstep;
            if (last && has_next) S.a_ready(nxt);
            PG8_LDB(B0, 0, 0); PG8_LDB(B1, 0, 1); PG8_SCHED; PG8_LDA(At, 0, 0); PG8_LDX(0); PG8_STAGE(PG8_SA(1, 1), a1 + hstep, voffA);
            PG8_WAIT_VL(); PG8_WAIT_L(0); PG8_BAR; PG8_MMA(0, 0, At, B0); PG8_MMA(0, 1, At, B1); PG8_MMAX(); PG8_BAR; PG8_SCHED;
            PG8_LDA(At, 0, 1); PG8_STAGE(PG8_SB(0, 0), b2, voffB); PG8_STAGE(PG8_SB(0, 1), b2 + hstep, voffB); PG8_STAGE(PG8_SA(0, 0), a2, voffA); PG8_STAGEX(0, x2);
            PG8_WAIT_VL(); PG8_WAIT_L(0); PG8_BAR; PG8_MMA(1, 0, At, B0); PG8_MMA(1, 1, At, B1); PG8_BAR; PG8_SCHED;
            PG8_LDB(B0, 1, 0); PG8_LDB(B1, 1, 1); PG8_SCHED; PG8_LDA(At, 1, 0); PG8_LDX(1); PG8_STAGE(PG8_SA(0, 1), a2 + hstep, voffA);
            PG8_WAIT_VL(); PG8_WAIT_L(0); PG8_BAR; PG8_MMA(0, 0, At, B0); PG8_MMA(0, 1, At, B1); PG8_MMAX(); PG8_BAR; PG8_SCHED;
            PG8_LDA(At, 1, 1); PG8_STAGE(PG8_SB(1, 0), b3, voffB); PG8_STAGE(PG8_SB(1, 1), b3 + hstep, voffB); PG8_STAGE(PG8_SA(1, 0), a3, voffA); PG8_STAGEX(1, x3);
            PG8_WAIT_VL(); PG8_WAIT_L(0); PG8_BAR; PG8_MMA(1, 0, At, B0); PG8_MMA(1, 1, At, B1); PG8_BAR; PG8_SCHED;
        }
        if (wr == 0) PG8_BAR;
        E(acc, cur, ui, wr, wc, fr, fq);
        if constexpr (STRIP) { if (cstrip >= 0) { E.strip(accX, cur, cstrip, ui, wr, wc, fr, fq); accX[0] = (f32x4){0.f, 0.f, 0.f, 0.f}; accX[1] = (f32x4){0.f, 0.f, 0.f, 0.f}; } }
        S.done(cur);
        if (!has_next) break;
#pragma unroll
        for (int a = 0; a < 2; ++a)
#pragma unroll
            for (int b = 0; b < 2; ++b)
#pragma unroll
                for (int m = 0; m < 4; ++m)
#pragma unroll
                    for (int n = 0; n < 2; ++n) acc[a][b][m][n] = (f32x4){0.f, 0.f, 0.f, 0.f};
        cur = nxt; cA = nA; cB = nB; cX = nX; cstrip = nstrip; ++ui;
        if (wr == 1) PG8_BAR;
    }
    PG8_WAIT_V(0);
    PG8_BAR;
#undef PG8_SA
#undef PG8_SB
#undef PG8_STAGE
#undef PG8_STAGEX
#undef PG8_LDA
#undef PG8_LDB
#undef PG8_LDX
#undef PG8_MMA
#undef PG8_MMAX
#undef PG8_WAIT_V
#undef PG8_WAIT_VL
#undef PG8_WAIT_L
#undef PG8_BAR
#undef PG8_SCHED
}
}

constexpr int D = 1024, NB = 8, SEQ = 2048, NMETA = 16, LSEQ = 2064, MP = NB * LSEQ, NS = 128, M = MP + NS;
constexpr int PW = 512, SW = 512, NIN = 3072, DFF = 2816, NUP = 5632, NG = 32, NST = 64, PHIST = 15;
constexpr int DEPTH = 2;
constexpr float RMS_EPS = 1e-6f;
static_assert(M % 256 == 0, "M");

constexpr size_t MiB = 1u << 20;
constexpr size_t WS_CTL = 0, CTL_ZERO_BYTES = 32 * 1024;
constexpr size_t WS_RS = 1 * MiB;
constexpr size_t WS_SM = 3 * MiB;
constexpr size_t WS_RSX = WS_SM + 3 * MiB / 4 + MiB / 8;
constexpr size_t WS_HS = WS_SM + MiB / 4;
constexpr size_t WS_GTOP = 4 * MiB, WS_VTOP = WS_GTOP + 3 * MiB / 2, WS_GBOT = WS_VTOP + 3 * MiB / 2;
constexpr size_t WS_W0 = 9 * MiB, WS_WSTRIDE = 27 * MiB;
constexpr size_t WO_IN = 0, WO_GLU = 6 * MiB, WO_OUT = 8 * MiB, WO_UP = 10 * MiB, WO_DOWN = 21 * MiB, WO_POOL = WO_DOWN + 11 * MiB / 2;
constexpr size_t WS_T0 = WS_W0 + 2 * WS_WSTRIDE, WS_TSTRIDE = 8 * MiB;
constexpr size_t TO_WS = 0, TO_TOEP = 2 * MiB, TO_WY = 6 * MiB;
constexpr size_t WS_XB = WS_T0 + 2 * WS_TSTRIDE;
constexpr size_t WS_YS = WS_XB + 65 * MiB / 2;
constexpr size_t WS_UP = WS_YS + 65 * MiB / 4;
constexpr size_t WS_US = WS_UP + 65 * MiB / 4;
constexpr size_t WS_GP = WS_US + 65 * MiB / 4;
constexpr size_t WS_GS = WS_GP + 65 * MiB / 2;
constexpr size_t WS_ACT = WS_UP;
constexpr size_t WS_END = WS_GS + 65 * MiB / 2;
static_assert(WS_ACT + (size_t)M * DFF * 2 <= WS_END, "act overlay");
static_assert(WS_GBOT + (size_t)65 * 2 * DFF * 4 <= WS_W0, "edge buffers");
static_assert(WO_POOL + 4 * 256 * 128 * 2 <= WS_WSTRIDE, "weights");
static_assert(WS_END <= 256 * MiB, "workspace");

constexpr int CW_BAR = 4096;

constexpr int LDS_BYTES = 163840;
constexpr int XCH_OFF = 131072;
constexpr int RSTD_OFF = XCH_OFF + 4096, RSTD_UNITS = 16, RSTD_STRIDE = 272, PRM_OFF = RSTD_OFF + RSTD_UNITS * RSTD_STRIDE * 4;
constexpr int XS_OFF = PRM_OFF + 2048;
constexpr int MMAIN = 16384;
static_assert(XS_OFF + 4096 <= LDS_BYTES - 256, "LDS map");
constexpr int LDSCTL_OFF = LDS_BYTES - 256, MISC_OFF = LDSCTL_OFF;

#define GAS __attribute__((address_space(1)))
#define LAS __attribute__((address_space(3)))
typedef unsigned short bf16;
typedef unsigned v4u __attribute__((ext_vector_type(4)));
typedef unsigned v2u __attribute__((ext_vector_type(2)));
typedef float f32x4 __attribute__((ext_vector_type(4)));
typedef float f32x2 __attribute__((ext_vector_type(2)));
typedef short bf16x8 __attribute__((ext_vector_type(8)));
typedef GAS unsigned gu32;
#define LDS_WAIT() asm volatile("s_waitcnt lgkmcnt(0)" ::: "memory")
#define VM_WAIT() asm volatile("s_waitcnt vmcnt(0)" ::: "memory")
__device__ __forceinline__ unsigned f2bf(float f) { unsigned u = __builtin_bit_cast(unsigned, f); return (u + 0x7fffu + ((u >> 16) & 1u)) >> 16; }
__device__ __forceinline__ unsigned pk2(float lo, float hi) { return f2bf(lo) | (f2bf(hi) << 16); }
__device__ __forceinline__ float bflo(unsigned w) { return __builtin_bit_cast(float, w << 16); }
__device__ __forceinline__ float bfhi(unsigned w) { return __builtin_bit_cast(float, w & 0xffff0000u); }
__device__ __forceinline__ void unpack8(v4u w, float (&f)[8]) { f[0] = bflo(w.x); f[1] = bfhi(w.x); f[2] = bflo(w.y); f[3] = bfhi(w.y); f[4] = bflo(w.z); f[5] = bfhi(w.z); f[6] = bflo(w.w); f[7] = bfhi(w.w); }
__device__ __forceinline__ v4u pack8(const float (&f)[8]) { v4u w; w.x = pg8::cvt_pk_bf16(f[0], f[1]); w.y = pg8::cvt_pk_bf16(f[2], f[3]); w.z = pg8::cvt_pk_bf16(f[4], f[5]); w.w = pg8::cvt_pk_bf16(f[6], f[7]); return w; }
__device__ __forceinline__ unsigned cvt_pk_bf16_t(float lo, float hi) { unsigned r; asm volatile("s_nop 0\n\tv_cvt_pk_bf16_f32 %0, %1, %2" : "=v"(r) : "v"(lo), "v"(hi)); return r; }
template <int CTRL> __device__ __forceinline__ float dpp_f(float v) { return __builtin_bit_cast(float, __builtin_amdgcn_update_dpp(0, __builtin_bit_cast(int, v), CTRL, 0xf, 0xf, false)); }
template <int CTRL> __device__ __forceinline__ float dppm(float v) { return __builtin_bit_cast(float, __builtin_amdgcn_mov_dpp(__builtin_bit_cast(int, v), CTRL, 0xf, 0xf, false)); }
typedef float f32x2 __attribute__((ext_vector_type(2)));
__device__ __forceinline__ f32x2 pr2(f32x4 v, int h) { f32x2 r; r.x = v[2 * h]; r.y = v[2 * h + 1]; return r; }
__device__ __forceinline__ f32x2 gelu2(f32x2 c) {
    const f32x2 K1 = {-2.302208198f, -2.302208198f}, K2 = {-0.102943240f, -0.102943240f}, one = {1.f, 1.f};
    const f32x2 q = c * __builtin_elementwise_fma(c * c, K2, K1);
    f32x2 e; e.x = __builtin_amdgcn_exp2f(q.x); e.y = __builtin_amdgcn_exp2f(q.y);
    const f32x2 d = e + one; f32x2 r; r.x = __builtin_amdgcn_rcpf(d.x); r.y = __builtin_amdgcn_rcpf(d.y);
    return c * r;
}
__device__ __forceinline__ f32x2 sigm2s(f32x2 x, float ns) {
    const f32x2 one = {1.f, 1.f}; const f32x2 q = x * ns; f32x2 e; e.x = __builtin_amdgcn_exp2f(q.x); e.y = __builtin_amdgcn_exp2f(q.y);
    const f32x2 d = e + one; f32x2 r; r.x = __builtin_amdgcn_rcpf(d.x); r.y = __builtin_amdgcn_rcpf(d.y); return r;
}
__device__ __forceinline__ float wave_sum(float v) {
#pragma unroll
    for (int o = 1; o < 64; o <<= 1) v += __shfl_xor(v, o);
    return v;
}
__device__ __forceinline__ float sigm(float x) { return __builtin_amdgcn_rcpf(1.0f + __builtin_amdgcn_exp2f(-1.4426950409f * x)); }
__device__ __forceinline__ float gelu_t(float x) { const float t = x * (1.5957691216f + 0.0713548163f * x * x); return x * __builtin_amdgcn_rcpf(1.0f + __builtin_amdgcn_exp2f(-1.4426950409f * t)); }
__device__ __forceinline__ float rstd_of(const float* RS, int r) {
    const f32x4* p = (const f32x4*)(RS + (size_t)r * 16); const f32x4 a = p[0], b = p[1], c = p[2], d = p[3];
    const float s = (((a.x + a.y) + (a.z + a.w)) + ((b.x + b.y) + (b.z + b.w))) + (((c.x + c.y) + (c.z + c.w)) + ((d.x + d.y) + (d.z + d.w)));
    return 1.0f / sqrtf(s * (1.0f / D) + RMS_EPS);
}

__device__ __forceinline__ float rs_sum(const float* RS, const float* RSX, int r, int h) {
    if (r < MMAIN) { const f32x4* p = (const f32x4*)(RS + (size_t)r * 16 + 8 * h); const f32x4 a = p[0], b = p[1]; return ((a.x + a.y) + (a.z + a.w)) + ((b.x + b.y) + (b.z + b.w)); }
    const f32x4* p = (const f32x4*)(RSX + (size_t)(r - MMAIN) * 32 + 16 * h); const f32x4 a = p[0], b = p[1], c = p[2], d = p[3];
    return (((a.x + a.y) + (a.z + a.w)) + ((b.x + b.y) + (b.z + b.w))) + (((c.x + c.y) + (c.z + c.w)) + ((d.x + d.y) + (d.z + d.w)));
}
template <class Sched> __device__ __forceinline__ void fill_rstd(LAS float* tab, const float* RS, const float* RSX, const Sched& S, int tid) {
    pg8::Unit u;
    for (int i = 0; i < RSTD_UNITS && S.next(i, u); ++i) {
        { const int row = tid >> 1, h = tid & 1; float s = rs_sum(RS, RSX, u.pm * 256 + row, h); s += __shfl_xor(s, 1);
          if (h == 0) tab[i * RSTD_STRIDE + row] = 1.0f / sqrtf(s * (1.0f / D) + RMS_EPS); }
        const int sr = S.strip_rows(u);
        if (sr >= 0 && tid < 32) { const int row = tid >> 1, h = tid & 1; float s = rs_sum(RS, RSX, sr + row, h); s += __shfl_xor(s, 1);
          if (h == 0) tab[i * RSTD_STRIDE + 256 + row] = 1.0f / sqrtf(s * (1.0f / D) + RMS_EPS); }
    }
    LDS_WAIT(); __syncthreads();
}

typedef f32x4 acc_t[2][2][4][2];

struct EpiIn {
    static constexpr bool PERM = true, AFTER_DRAIN = false;
    bf16 *UP, *US, *GP, *GS; const LAS float* rstd; float* pool_p; float* pool_s;
    __device__ __forceinline__ void operator()(acc_t& acc, const pg8::Unit& u, int ui, int wr, int wc, int fr_, int fq_) const {
        int fr = fr_, fq = fq_; asm volatile("" : "+v"(fr), "+v"(fq));
        const int colt = u.pn * 256 + wc * 32 + 8 * fq;
        float rsv[2][4];
#pragma unroll
        for (int ai = 0; ai < 2; ++ai)
#pragma unroll
            for (int m = 0; m < 4; ++m) rsv[ai][m] = rstd[ui * RSTD_STRIDE + ai * 128 + wr * 64 + m * 16 + fr];
        __builtin_amdgcn_sched_barrier(0);
#pragma unroll
        for (int ai = 0; ai < 2; ++ai)
#pragma unroll
            for (int m = 0; m < 4; ++m) {
                const int r = u.pm * 256 + ai * 128 + wr * 64 + m * 16 + fr;
                const float rs = rsv[ai][m];
#pragma unroll
                for (int bj = 0; bj < 2; ++bj) {
                    const int c0 = colt + 128 * bj;
                    f32x4 v0 = acc[ai][bj][m][0], v1 = acc[ai][bj][m][1];
                    if (u.pn < 4) { v0 *= rs; v1 *= rs; }
                    if (u.pn < 2) {
                        v4u w; w.x = pg8::cvt_pk_bf16(v0[0], v0[1]); w.y = pg8::cvt_pk_bf16(v0[2], v0[3]); w.z = pg8::cvt_pk_bf16(v1[0], v1[1]); w.w = pg8::cvt_pk_bf16(v1[2], v1[3]);
                        *(v4u*)(UP + (size_t)r * PW + c0) = w;
                        if (r < MP) { const int b = r / LSEQ, t = r - b * LSEQ;
                            if (t >= LSEQ - PHIST) { float* p = pool_p + ((size_t)(b * PHIST + (t - (LSEQ - PHIST)))) * PW + c0; *(f32x4*)p = v0; *(f32x4*)(p + 4) = v1; } }
                        else { float* p = pool_s + ((size_t)((r - MP) * PHIST + (PHIST - 1))) * PW + c0; *(f32x4*)p = v0; *(f32x4*)(p + 4) = v1; }
                    } else if (u.pn < 4) {
                        v4u w; w.x = pg8::cvt_pk_bf16(v0[0], v0[1]); w.y = pg8::cvt_pk_bf16(v0[2], v0[3]); w.z = pg8::cvt_pk_bf16(v1[0], v1[1]); w.w = pg8::cvt_pk_bf16(v1[2], v1[3]);
                        *(v4u*)(US + (size_t)r * SW + (c0 - 512)) = w;
                    } else {
#pragma unroll
                        for (int j = 0; j < 1; ++j) {}
                        const float ns = -1.4426950409f * rs;
                        const f32x2 s0 = sigm2s(pr2(v0, 0), ns), s1 = sigm2s(pr2(v0, 1), ns), s2 = sigm2s(pr2(v1, 0), ns), s3 = sigm2s(pr2(v1, 1), ns);
                        v4u w; w.x = cvt_pk_bf16_t(s0.x, s0.y); w.y = cvt_pk_bf16_t(s1.x, s1.y); w.z = cvt_pk_bf16_t(s2.x, s2.y); w.w = cvt_pk_bf16_t(s3.x, s3.y);
                        if (u.pn < 8) *(v4u*)(GP + (size_t)r * D + (c0 - 1024)) = w; else *(v4u*)(GS + (size_t)r * D + (c0 - 2048)) = w;
                    }
                }
                asm volatile("" ::: "memory");
            }
    }
    __device__ __forceinline__ void strip(const f32x4 (&ax)[2], const pg8::Unit& u, int sr, int ui, int wr, int wc, int fr_, int fq_) const {
        int fr = fr_, fq = fq_; asm volatile("" : "+v"(fr), "+v"(fq));
        const int r = sr + fr; const float rs = rstd[ui * RSTD_STRIDE + 256 + fr];
#pragma unroll
        for (int bj = 0; bj < 2; ++bj) {
            const int c0 = u.pn * 256 + 128 * bj + wc * 32 + 8 * fq + 4 * wr;
            f32x4 v0 = ax[bj] * rs;
            if (u.pn < 2) {
                v2u w; w.x = pg8::cvt_pk_bf16(v0[0], v0[1]); w.y = pg8::cvt_pk_bf16(v0[2], v0[3]);
                *(v2u*)(UP + (size_t)r * PW + c0) = w;
                if (r < MP) { const int b = r / LSEQ, t = r - b * LSEQ; if (t >= LSEQ - PHIST) *(f32x4*)(pool_p + ((size_t)(b * PHIST + (t - (LSEQ - PHIST)))) * PW + c0) = v0; }
                else *(f32x4*)(pool_s + ((size_t)((r - MP) * PHIST + (PHIST - 1))) * PW + c0) = v0;
            } else if (u.pn < 4) {
                v2u w; w.x = pg8::cvt_pk_bf16(v0[0], v0[1]); w.y = pg8::cvt_pk_bf16(v0[2], v0[3]);
                *(v2u*)(US + (size_t)r * SW + (c0 - 512)) = w;
            } else {
#pragma unroll
                for (int j = 0; j < 4; ++j) v0[j] = sigm(v0[j]);
                v2u w; w.x = cvt_pk_bf16_t(v0[0], v0[1]); w.y = cvt_pk_bf16_t(v0[2], v0[3]);
                if (u.pn < 8) *(v2u*)(GP + (size_t)r * D + (c0 - 1024)) = w; else *(v2u*)(GS + (size_t)r * D + (c0 - 2048)) = w;
            }
        }
    }
};

struct EpiGlu {
    static constexpr bool PERM = true, AFTER_DRAIN = false;
    bf16* GP; const bf16* GS;
    __device__ __forceinline__ void operator()(acc_t& acc, const pg8::Unit& u, int ui, int wr, int wc, int fr_, int fq_) const {
        int fr = fr_, fq = fq_; asm volatile("" : "+v"(fr), "+v"(fq));
        const int c0 = u.pn * 128 + wc * 32 + 8 * fq;
#pragma unroll
        for (int ai = 0; ai < 2; ++ai) {
            v4u pw[4], gw[4];
#pragma unroll
            for (int m = 0; m < 4; ++m) { const size_t o = (size_t)(u.pm * 256 + ai * 128 + wr * 64 + m * 16 + fr) * D + c0; pw[m] = *(const v4u*)(GP + o); gw[m] = *(const v4u*)(GS + o); }
#pragma unroll
            for (int m = 0; m < 4; ++m) {
                const size_t o = (size_t)(u.pm * 256 + ai * 128 + wr * 64 + m * 16 + fr) * D + c0;
                float pv[8], gv[8], ov[8]; unpack8(pw[m], pv); unpack8(gw[m], gv);
#pragma unroll
                for (int n = 0; n < 2; ++n)
#pragma unroll
                    for (int h = 0; h < 2; ++h) {
                        const f32x2 sg = sigm2s(pr2(acc[ai][1][m][n], h), -1.4426950409f); f32x2 p2, g2; p2.x = pv[4 * n + 2 * h]; p2.y = pv[4 * n + 2 * h + 1]; g2.x = gv[4 * n + 2 * h]; g2.y = gv[4 * n + 2 * h + 1];
                        const f32x2 r = __builtin_elementwise_fma(g2 * pr2(acc[ai][0][m][n], h), sg, p2); ov[4 * n + 2 * h] = r.x; ov[4 * n + 2 * h + 1] = r.y; }
                *(v4u*)(GP + o) = pack8(ov);
            }
            asm volatile("" ::: "memory");
        }
    }
    __device__ __forceinline__ void strip(const f32x4 (&ax)[2], const pg8::Unit& u, int sr, int ui, int wr, int wc, int fr_, int fq_) const {
        int fr = fr_, fq = fq_; asm volatile("" : "+v"(fr), "+v"(fq));
        const size_t o = (size_t)(sr + fr) * D + u.pn * 128 + wc * 32 + 8 * fq + 4 * wr;
        const v2u pw = *(const v2u*)(GP + o), gw = *(const v2u*)(GS + o);
        const float pv[4] = {bflo(pw.x), bfhi(pw.x), bflo(pw.y), bfhi(pw.y)}, gv[4] = {bflo(gw.x), bfhi(gw.x), bflo(gw.y), bfhi(gw.y)};
        float ov[4];
#pragma unroll
        for (int j = 0; j < 4; ++j) ov[j] = pv[j] + gv[j] * ax[0][j] * sigm(ax[1][j]);
        v2u w; w.x = pg8::cvt_pk_bf16(ov[0], ov[1]); w.y = pg8::cvt_pk_bf16(ov[2], ov[3]);
        *(v2u*)(GP + o) = w;
    }
};

struct EpiRes {
    static constexpr bool PERM = true, AFTER_DRAIN = false;
    bf16* XB; float* RS; float* RSX;
    __device__ __forceinline__ void operator()(acc_t& acc, const pg8::Unit& u, int ui, int wr, int wc, int fr_, int fq_) const {
        int fr = fr_, fq = fq_; asm volatile("" : "+v"(fr), "+v"(fq));
        const int colt = u.pn * 256 + wc * 32 + 8 * fq;
#pragma unroll
        for (int ai = 0; ai < 2; ++ai) {
            v4u xw[4][2];
#pragma unroll
            for (int m = 0; m < 4; ++m)
#pragma unroll
                for (int bj = 0; bj < 2; ++bj) xw[m][bj] = *(const v4u*)(XB + (size_t)(u.pm * 256 + ai * 128 + wr * 64 + m * 16 + fr) * D + colt + 128 * bj);
#pragma unroll
            for (int m = 0; m < 4; ++m) {
                const int r = u.pm * 256 + ai * 128 + wr * 64 + m * 16 + fr;
                float ss = 0.f;
#pragma unroll
                for (int bj = 0; bj < 2; ++bj) {
                    float xv[8], xr[8]; unpack8(xw[m][bj], xv);
#pragma unroll
                    for (int n = 0; n < 2; ++n)
#pragma unroll
                        for (int j = 0; j < 4; ++j) xv[4 * n + j] += acc[ai][bj][m][n][j];
                    const v4u w = pack8(xv); *(v4u*)(XB + (size_t)r * D + colt + 128 * bj) = w; unpack8(w, xr);
                    ss += ((xr[0] * xr[0] + xr[1] * xr[1]) + (xr[2] * xr[2] + xr[3] * xr[3])) + ((xr[4] * xr[4] + xr[5] * xr[5]) + (xr[6] * xr[6] + xr[7] * xr[7]));
                }
                ss += __shfl_xor(ss, 16); ss += __shfl_xor(ss, 32);
                if (fq == 0) { if (r < MMAIN) RS[(size_t)r * 16 + u.pn * 4 + wc] = ss; else { RSX[(size_t)(r - MMAIN) * 32 + (u.pn * 4 + wc) * 2] = ss; RSX[(size_t)(r - MMAIN) * 32 + (u.pn * 4 + wc) * 2 + 1] = 0.f; } }
            }
            asm volatile("" ::: "memory");
        }
    }
    __device__ __forceinline__ void strip(const f32x4 (&ax)[2], const pg8::Unit& u, int sr, int ui, int wr, int wc, int fr_, int fq_) const {
        int fr = fr_, fq = fq_; asm volatile("" : "+v"(fr), "+v"(fq));
        const int r = sr + fr; float ss = 0.f;
#pragma unroll
        for (int bj = 0; bj < 2; ++bj) {
            bf16* xp = XB + (size_t)r * D + u.pn * 256 + 128 * bj + wc * 32 + 8 * fq + 4 * wr;
            const v2u xw = *(const v2u*)xp;
            const float x0 = bflo(xw.x) + ax[bj][0], x1 = bfhi(xw.x) + ax[bj][1], x2 = bflo(xw.y) + ax[bj][2], x3 = bfhi(xw.y) + ax[bj][3];
            v2u w; w.x = pg8::cvt_pk_bf16(x0, x1); w.y = pg8::cvt_pk_bf16(x2, x3); *(v2u*)xp = w;
            const float y0 = bflo(w.x), y1 = bfhi(w.x), y2 = bflo(w.y), y3 = bfhi(w.y); ss += (y0 * y0 + y1 * y1) + (y2 * y2 + y3 * y3);
        }
        ss += __shfl_xor(ss, 16); ss += __shfl_xor(ss, 32);
        if (fq == 0) RSX[(size_t)(r - MMAIN) * 32 + (u.pn * 4 + wc) * 2 + wr] = ss;
    }
};

struct EpiUp {
    static constexpr bool PERM = true, AFTER_DRAIN = false;
    bf16* ACT; const LAS float* rstd; const float* cw; const float* cb; const float* sconv; float* conv_p; float* conv_s; float* Gtop; float* Vtop; float* Gbot; LAS float* xch; LAS float* prm;
    __device__ __forceinline__ void operator()(acc_t& acc, const pg8::Unit& u, int ui, int wr, int wc, int fr_, int fq_) const {
        int fr = fr_, fq = fq_; asm volatile("" : "+v"(fr), "+v"(fq));
        const int lane = fr + 16 * fq;
        const int gc0 = 128 * u.pn + 32 * wc + 8 * fq;
        const int r0 = u.pm * 256;
        { float rsv[2][4];
#pragma unroll
          for (int ai = 0; ai < 2; ++ai)
#pragma unroll
            for (int m = 0; m < 4; ++m) rsv[ai][m] = rstd[ui * RSTD_STRIDE + ai * 128 + wr * 64 + m * 16 + fr];
          __builtin_amdgcn_sched_barrier(0);
#pragma unroll
          for (int ai = 0; ai < 2; ++ai)
#pragma unroll
            for (int m = 0; m < 4; ++m)
#pragma unroll
                for (int bj = 0; bj < 2; ++bj) { acc[ai][bj][m][0] *= rsv[ai][m]; acc[ai][bj][m][1] *= rsv[ai][m]; } }
#pragma unroll
        for (int ai = 0; ai < 2; ++ai)
            if (fr >= 14) { LAS float* p = xch + ((((ai * 2 + wr) * 4 + wc) * 2 + (fr - 14)) * 4 + fq) * 8; *(LAS f32x4*)p = acc[ai][0][3][0]; *(LAS f32x4*)(p + 4) = acc[ai][0][3][1]; }
        if (wr == 1 && fr >= 14) { float* p = Gbot + ((size_t)(u.pm * 2 + fr - 14)) * DFF + gc0; *(f32x4*)p = acc[1][0][3][0]; *(f32x4*)(p + 4) = acc[1][0][3][1]; }
        if (wr == 0 && fr < 2) { const size_t o = ((size_t)(u.pm * 2 + fr)) * DFF + gc0;
            *(f32x4*)(Gtop + o) = acc[0][0][0][0]; *(f32x4*)(Gtop + o + 4) = acc[0][0][0][1]; *(f32x4*)(Vtop + o) = acc[0][1][0][0]; *(f32x4*)(Vtop + o + 4) = acc[0][1][0][1]; }
        { const int t = (wr * 4 + wc) * 64 + lane, k = t >> 7, c = t & 127; prm[t] = (k < 3) ? cw[k * DFF + 128 * u.pn + c] : cb[128 * u.pn + c]; }
        asm volatile("s_waitcnt lgkmcnt(0)" ::: "memory"); __builtin_amdgcn_s_barrier(); asm volatile("" ::: "memory");
        const bool special = (u.pm == 0) || (u.pm * 256 >= MMAIN) || ((r0 + 257) / LSEQ != (r0 - 2) / LSEQ);
#pragma unroll
        for (int ai = 0; ai < 2; ++ai) {
            f32x4 P1[2], P2[2];
            if (wr == 1 || ai == 1) {
                const int sai = (wr == 1) ? ai : 0, swr = (wr == 1) ? 0 : 1;
                const LAS float* p = xch + ((((sai * 2 + swr) * 4 + wc) * 2 + 0) * 4 + fq) * 8;
#pragma unroll
                for (int n = 0; n < 2; ++n) { const f32x4 e2 = *(const LAS f32x4*)(p + 4 * n), e1 = *(const LAS f32x4*)(p + 32 + 4 * n); P1[n] = e1; P2[n] = (fr == 0) ? e2 : e1; }
            } else { P1[0] = P1[1] = P2[0] = P2[1] = (f32x4){0.f, 0.f, 0.f, 0.f}; }
#pragma unroll
            for (int m = 0; m < 4; ++m) {
                const int r = r0 + ai * 128 + wr * 64 + m * 16 + fr;
                f32x4 R1[2], R2[2], g1[2], g2[2];
#pragma unroll
                for (int n = 0; n < 2; ++n)
#pragma unroll
                    for (int j = 0; j < 4; ++j) { const float cur = acc[ai][0][m][n][j]; R1[n][j] = dppm<0x121>(cur); R2[n][j] = dppm<0x122>(cur);
                        g1[n][j] = (fr >= 1) ? R1[n][j] : P1[n][j]; g2[n][j] = (fr >= 2) ? R2[n][j] : P2[n][j]; }
                if (special) {
                if (r < MP) {
                    const int b = r / LSEQ, t = r - b * LSEQ;
                    if (t == 0) { g1[0] = g1[1] = (f32x4){0.f, 0.f, 0.f, 0.f}; }
                    if (t <= 1) { g2[0] = g2[1] = (f32x4){0.f, 0.f, 0.f, 0.f}; }
                    if (t >= LSEQ - 2) { float* p = conv_p + ((size_t)(b * 2 + (t - (LSEQ - 2)))) * DFF + gc0; *(f32x4*)p = acc[ai][0][m][0]; *(f32x4*)(p + 4) = acc[ai][0][m][1]; }
                } else {
                    const int bs = r - MP; const float* h = sconv + ((size_t)bs * 2) * DFF + gc0;
                    g2[0] = *(const f32x4*)h; g2[1] = *(const f32x4*)(h + 4); g1[0] = *(const f32x4*)(h + DFF); g1[1] = *(const f32x4*)(h + DFF + 4);
                    float* p = conv_s + ((size_t)(bs * 2 + 1)) * DFF + gc0; *(f32x4*)p = acc[ai][0][m][0]; *(f32x4*)(p + 4) = acc[ai][0][m][1];
                }
                }
                float o[8];
                f32x4 w0[2], w1[2], w2[2], bb[2];
#pragma unroll
                for (int n = 0; n < 2; ++n) { const int lc = 32 * wc + 8 * fq + 4 * n; w0[n] = *(const LAS f32x4*)(prm + lc); w1[n] = *(const LAS f32x4*)(prm + 128 + lc); w2[n] = *(const LAS f32x4*)(prm + 256 + lc); bb[n] = *(const LAS f32x4*)(prm + 384 + lc); }
                __builtin_amdgcn_sched_barrier(0);
#pragma unroll
                for (int n = 0; n < 2; ++n)
#pragma unroll
                    for (int h = 0; h < 2; ++h) {
                        f32x2 c = __builtin_elementwise_fma(pr2(w0[n], h), pr2(g2[n], h), pr2(bb[n], h)); c = __builtin_elementwise_fma(pr2(w1[n], h), pr2(g1[n], h), c); c = __builtin_elementwise_fma(pr2(w2[n], h), pr2(acc[ai][0][m][n], h), c);
                        const f32x2 r = gelu2(c) * pr2(acc[ai][1][m][n], h); o[4 * n + 2 * h] = r.x; o[4 * n + 2 * h + 1] = r.y; }
                __builtin_nontemporal_store(pack8(o), (v4u*)(ACT + (size_t)r * DFF + gc0));
                P1[0] = R1[0]; P1[1] = R1[1]; P2[0] = R2[0]; P2[1] = R2[1];
                if (m & 1) asm volatile("" ::: "memory");
            }
        }
    }
};
#define XB_TMO      128
#define XB_XCNT(j)  (256  + 64 * (j))
#define XB_XSUB(j)  (1280 + 64 * (j))
#define XB_XGEN(j)  (2304 + 64 * (j))
#define XB_TOP      3328
#define XB_TOPGEN   3392
#define XCD_BAR_WORDS 3456
#define XB_SPIN_CAP (1u << 18)

__device__ __forceinline__ unsigned xb_ld(unsigned* p)              { return __hip_atomic_load(p, __ATOMIC_RELAXED, __HIP_MEMORY_SCOPE_AGENT); }
__device__ __forceinline__ unsigned xb_add(unsigned* p, unsigned v) { return __hip_atomic_fetch_add(p, v, __ATOMIC_RELAXED, __HIP_MEMORY_SCOPE_AGENT); }
__device__ __forceinline__ unsigned xb_xcc_id() { return (unsigned)__builtin_amdgcn_s_getreg((3 << 11) | 20) & 0xFu; }
#define XB_SPIN(cond, bar) do { unsigned _sp = 0; while (cond) { __builtin_amdgcn_s_sleep(1); \
    if ((++_sp & 255u) == 0u) { if (xb_ld(&(bar)[XB_TMO])) break; if (_sp > XB_SPIN_CAP) { atomicAdd(&(bar)[XB_TMO], 1u); break; } } } } while (0)

struct XcdBarrier {
    unsigned* bar; unsigned x;
    volatile LAS unsigned* st;
};

__device__ __forceinline__ XcdBarrier xcd_barrier_post(unsigned* bar, volatile LAS unsigned* st) {
    XcdBarrier b; b.bar = bar; b.x = xb_xcc_id(); b.st = st;
    if (threadIdx.x == 0) (void)xb_add(&bar[XB_XCNT(b.x)], 1u);
    return b;
}
__device__ __forceinline__ void xcd_barrier_complete(unsigned* bar, unsigned x, unsigned& nloc, unsigned& nx) {
    const unsigned G = gridDim.x * gridDim.y * gridDim.z;
    unsigned sum, cnt, mine, sp = 0u;
    for (;;) {
        sum = 0u; cnt = 0u; mine = 0u;
#pragma unroll
        for (unsigned j = 0; j < 16; ++j) { const unsigned c = xb_ld(&bar[XB_XCNT(j)]); sum += c; cnt += (c > 0u) ? 1u : 0u; mine = (j == x) ? c : mine; }
        if (sum == G) break;
        __builtin_amdgcn_s_sleep(1);
        if ((++sp & 255u) == 0u) { if (xb_ld(&bar[XB_TMO])) break; if (sp > XB_SPIN_CAP) { atomicAdd(&bar[XB_TMO], 1u); break; } }
    }
    nloc = mine > 0u ? mine : 1u; nx = cnt > 0u ? cnt : 1u;
}

__device__ __forceinline__ void xcd_barrier(const XcdBarrier& b) {
    asm volatile("s_waitcnt vmcnt(0)" ::: "memory");
    __syncthreads();
    int tid0_ = threadIdx.x; asm volatile("" : "+v"(tid0_));
    if (tid0_ == 0) {
        __attribute__((address_space(1))) unsigned* barg_ = (__attribute__((address_space(1))) unsigned*)b.bar; asm volatile("" : "+s"(barg_)); unsigned* bar = (unsigned*)barg_;
        unsigned bx_ = b.x; asm volatile("" : "+s"(bx_));
        __builtin_amdgcn_s_waitcnt(0);
        unsigned nloc = b.st[0], nx = b.st[1];
        if (nloc == 0u) { xcd_barrier_complete(bar, bx_, nloc, nx); b.st[0] = nloc; b.st[1] = nx; }
        const unsigned old = xb_add(&bar[XB_XSUB(bx_)], 1u);
        const unsigned gen = old / nloc;
        if (old + 1u == (gen + 1u) * nloc) {
            __builtin_amdgcn_fence(__ATOMIC_RELEASE, "agent");
            asm volatile("s_waitcnt vmcnt(0)" ::: "memory");
            const unsigned og = xb_add(&bar[XB_TOP], 1u);
            const unsigned tg = og / nx;
            if (og + 1u == (tg + 1u) * nx) xb_add(&bar[XB_TOPGEN], 1u);
            else XB_SPIN(xb_ld(&bar[XB_TOPGEN]) == tg, bar);
            __builtin_amdgcn_fence(__ATOMIC_ACQUIRE, "agent");
            xb_add(&bar[XB_XGEN(bx_)], 1u);
            asm volatile("s_waitcnt vmcnt(0)" ::: "memory");
        } else {
            XB_SPIN(xb_ld(&bar[XB_XGEN(bx_)]) == gen, bar);
            __builtin_amdgcn_fence(__ATOMIC_ACQUIRE, "agent");
            asm volatile("s_waitcnt vmcnt(0)" ::: "memory");
        }
    }
    __syncthreads();
}

constexpr int TR_BYTES = 64 * 65 * 4;
__device__ __forceinline__ void transpose_item(const float* W, int K, int N, bf16* WT, LAS float* scr, int item, int lane, const float* rs, const float* cs, int mode) {
    const int nblk = N / 64, kb = item / nblk, nb = item % nblk, k0 = 64 * kb, n0 = 64 * nb;
    const int lr = lane >> 4, lc = (lane & 15) * 4;
    f32x4 csv = {1.f, 1.f, 1.f, 1.f}; if (cs) csv = *(const f32x4*)(cs + n0 + lc);
    {
        f32x4 v[16];
#pragma unroll
        for (int i = 0; i < 16; ++i) v[i] = __builtin_nontemporal_load((const f32x4*)(W + (size_t)(k0 + 4 * i + lr) * N + n0 + lc));
        __builtin_amdgcn_sched_barrier(0);
#pragma unroll
        for (int i = 0; i < 16; ++i) { const int kk = 4 * i + lr; f32x4 w = v[i] * csv; if (rs) w = w * rs[k0 + kk];
            LAS float* d = scr + kk * 65 + lc; d[0] = w.x; d[1] = w.y; d[2] = w.z; d[3] = w.w; }
    }
    LDS_WAIT(); asm volatile("" ::: "memory");
    int drow0 = n0;
    if (mode == 1) { const int half = N / 2; const int v = n0 < half ? n0 : n0 - half; drow0 = 256 * (v / 128) + (n0 < half ? 0 : 128) + (v % 128); }
    const int c = lane & 7;
#pragma unroll
    for (int j = 0; j < 8; ++j) { const int n = (lane >> 3) + 8 * j; const LAS float* s = scr + (8 * c) * 65 + n;
        v4u o; o.x = pk2(s[0 * 65], s[1 * 65]); o.y = pk2(s[2 * 65], s[3 * 65]); o.z = pk2(s[4 * 65], s[5 * 65]); o.w = pk2(s[6 * 65], s[7 * 65]);
        *(v4u*)(WT + (size_t)(drow0 + n) * K + k0 + 8 * c) = o; }
    LDS_WAIT(); asm volatile("" ::: "memory");
}

__device__ __forceinline__ void sincos_f(float x, float& s, float& c) {
    const float kf = rintf(x * 0.6366197724f);
    const float y = ((x - kf * 1.5703125f) - kf * 4.837512969970703125e-4f) - kf * 7.54978995489188216e-8f;
    const int k = (int)kf;
    const float y2 = y * y;
    const float sp = y * (1.0f + y2 * (-1.6666667163e-1f + y2 * (8.3333337680e-3f + y2 * (-1.9841270114e-4f + y2 * (2.7557314297e-6f + y2 * -2.5050759689e-8f)))));
    const float cp = 1.0f + y2 * (-0.5f + y2 * (4.1666667908e-2f + y2 * (-1.3888889225e-3f + y2 * (2.4801587642e-5f + y2 * (-2.7557314297e-7f + y2 * 2.0876755880e-9f)))));
    const int q = k & 3;
    s = (q == 0) ? sp : (q == 1) ? cp : (q == 2) ? -sp : -cp;
    c = (q == 0) ? cp : (q == 1) ? -sp : (q == 2) ? -cp : sp;
}

__device__ __forceinline__ void ssm_tables(LAS unsigned char* lds, int tid, int l, int g, int quad,
        const float* A_re, const float* A_im, const float* log_dt, const float* B_re, const float* B_im, const float* C_re, const float* C_im, const float* Dsk,
        bf16* TWS, bf16* TTOEP, bf16* TWY, float* SMT) {
    LAS f32x2* Pk = (LAS f32x2*)lds;
    LAS f32x2* Bb = Pk + 17 * 64;
    LAS f32x2* Cc = Bb + 64 * 16;
    LAS float* Mt = (LAS float*)(Cc + 16 * 65);
    __syncthreads();
    const int lg = l * NG + g;
    if (tid < 64) {
        const int n = tid;
        const float dt = expf(log_dt[lg]);
        const float lr = A_re[lg * 64 + n], li = A_im[lg * 64 + n];
        const float mag = expf(lr * dt); float sn, cs; sincos_f(li * dt, sn, cs);
        const float ar = mag * cs, ai = mag * sn, den = lr * lr + li * li, nr = ar - 1.0f, ni = ai;
        const float qr = (nr * lr + ni * li) / den, qi = (ni * lr - nr * li) / den;
        float pr = 1.0f, pi = 0.0f;
        for (int k = 0; k <= 16; ++k) { Pk[k * 64 + n] = (f32x2){pr, pi}; const float t = pr * ar - pi * ai; pi = pr * ai + pi * ar; pr = t; }
        if (quad == 0) { float* o = SMT + ((size_t)lg * 64 + n) * 8; const f32x2 p16 = Pk[16 * 64 + n];
            *(f32x4*)o = (f32x4){ar, ai, qr, qi}; *(f32x4*)(o + 4) = (f32x4){p16.x, p16.y, 0.f, 0.f}; }
        for (int qc = 0; qc < 16; ++qc) { const float br = B_re[((size_t)lg * 64 + n) * 16 + qc], bi = B_im[((size_t)lg * 64 + n) * 16 + qc];
            Bb[n * 16 + qc] = (f32x2){qr * br - qi * bi, qr * bi + qi * br}; }
    }
    for (int i = tid; i < 1024; i += 512) Cc[(i >> 6) * 65 + (i & 63)] = (f32x2){C_re[(size_t)lg * 1024 + i], C_im[(size_t)lg * 1024 + i]};
    LDS_WAIT(); __syncthreads();
    {
        const int tl = tid >> 7, tau = 4 * quad + tl, pp = (tid >> 3) & 15, q0 = (tid & 7) * 2; float s0 = 0.f, s1 = 0.f;
        for (int n = 0; n < 64; ++n) { const f32x2 c = Cc[pp * 65 + n], pk = Pk[tau * 64 + n];
            const float cpr = c.x * pk.x - c.y * pk.y, cpi = c.x * pk.y + c.y * pk.x;
            const f32x4 b = *(const LAS f32x4*)(Bb + n * 16 + q0);
            s0 += cpr * b.x - cpi * b.y; s1 += cpr * b.z - cpi * b.w; }
        if (tau == 0) { const float dv = Dsk[l * SW + 16 * g + pp]; if (q0 == pp) s0 += dv; if (q0 + 1 == pp) s1 += dv; }
        *(LAS f32x2*)(Mt + tl * 256 + pp * 16 + q0) = (f32x2){s0, s1};
    }
    LDS_WAIT(); __syncthreads();
    for (int it = tid; it < 8192; it += 512) {
        const int row = it >> 5, oct = it & 31, j = row >> 4, p = row & 15, i_ = oct >> 1, q0 = (oct & 1) * 8, tau = j - i_;
        if (((tau >= 0) ? (tau >> 2) : ((-tau) >> 2)) != quad) continue;
        float v[8];
#pragma unroll
        for (int e = 0; e < 8; ++e) v[e] = (tau >= 0) ? Mt[(tau - 4 * quad) * 256 + p * 16 + q0 + e] : 0.f;
        v4u o; o.x = pk2(v[0], v[1]); o.y = pk2(v[2], v[3]); o.z = pk2(v[4], v[5]); o.w = pk2(v[6], v[7]);
        *(v4u*)(TTOEP + ((size_t)(g * 256 + row)) * 256 + 8 * oct) = o;
    }
    for (int part = 2 * quad; part < 2 * quad + 2; ++part) {
    {
        const int s = 16 * part + (tid >> 5), oct = tid & 31, n = s & 63, i_ = oct >> 1, q0 = (oct & 1) * 8;
        float v[8];
#pragma unroll
        for (int e = 0; e < 8; ++e) { const f32x2 pk = Pk[(15 - i_) * 64 + n], b = Bb[n * 16 + q0 + e]; v[e] = (s < 64) ? (pk.x * b.x - pk.y * b.y) : (pk.x * b.y + pk.y * b.x); }
        v4u o; o.x = pk2(v[0], v[1]); o.y = pk2(v[2], v[3]); o.z = pk2(v[4], v[5]); o.w = pk2(v[6], v[7]);
        *(v4u*)(TWS + ((size_t)(g * 128 + s)) * 256 + 8 * oct) = o;
    }
    {
        const int row = 32 * part + (tid >> 4), oct = tid & 15, j = row >> 4, p = row & 15;
        float v[8];
#pragma unroll
        for (int e = 0; e < 8; ++e) { const int si = 8 * oct + e, n = si & 63; const f32x2 c = Cc[p * 65 + n], pk = Pk[(j + 1) * 64 + n];
            v[e] = (si < 64) ? (c.x * pk.x - c.y * pk.y) : -(c.x * pk.y + c.y * pk.x); }
        v4u o; o.x = pk2(v[0], v[1]); o.y = pk2(v[2], v[3]); o.z = pk2(v[4], v[5]); o.w = pk2(v[6], v[7]);
        *(v4u*)(TWY + ((size_t)(g * 256 + row)) * 128 + 8 * oct) = o;
    }
    }
}

constexpr int UPITCH = 528;
constexpr int SSM_U_BYTES = 144 * UPITCH;
struct SampleArgs { const float *B_re, *B_im, *C_re, *C_im, *Dsk, *st_re, *st_im; float *re_s, *im_s; int first, stride; };
__device__ __forceinline__ void ssm_sample_item(int lane, int l, int bs, int g, const bf16* US, bf16* YS, const float* SMT,
        const float* B_re, const float* B_im, const float* C_re, const float* C_im, const float* Dsk, const float* st_re, const float* st_im, float* re_s, float* im_s);
__device__ __forceinline__ void ssm_unit(LAS unsigned char* lds, int tid, int l, int b, int g, const bf16* US, bf16* YS,
        const bf16* TWS, const bf16* TTOEP, const bf16* TWY, const float* SMT, float* re_p, float* im_p, const SampleArgs& sa, volatile LAS unsigned* dbg = nullptr) {
#ifdef DBG_S
    unsigned ts_lo_ = 0;
#define DBGS(i) do { if ((i) + 1 == DBG_S) ts_lo_ = (unsigned)__builtin_amdgcn_s_memrealtime(); if ((i) == DBG_S) { const unsigned t_ = (unsigned)__builtin_amdgcn_s_memrealtime(); if (dbg && threadIdx.x == 0) dbg[0] = t_ - ts_lo_; } } while (0)
#else
#define DBGS(i) do {} while (0)
#endif
    const int wid = __builtin_amdgcn_readfirstlane(tid >> 6), lane = tid & 63, fr = lane & 15, fq = lane >> 4;
    LAS unsigned char* Ul = lds;
    LAS unsigned char* SHl = lds + SSM_U_BYTES + UPITCH;
    __syncthreads(); DBGS(-1);
    unsigned z_ = 0u; asm volatile("" : "+v"(z_)); const v4u zv = {z_, z_, z_, z_};
    {
        v4u uv[9];
#pragma unroll
        for (int i = 0; i < 9; ++i) { const int p = tid + 512 * i, tok = p >> 1, half = p & 1; uv[i] = zv;
            if (p < LSEQ * 2) uv[i] = *(const v4u*)(US + ((size_t)(b * LSEQ + tok)) * SW + 16 * g + 8 * half); }
        __builtin_amdgcn_sched_barrier(0);
#pragma unroll
        for (int i = 0; i < 9; ++i) { const int p = tid + 512 * i, tok = p >> 1, half = p & 1;
            if (p < LSEQ * 2) *(LAS v4u*)(Ul + (tok >> 4) * UPITCH + (tok & 15) * 32 + half * 16) = uv[i]; }
    }
    for (int p = tid; p < 15 * 32; p += 512) *(LAS v4u*)(Ul + (129 + (p >> 5)) * UPITCH + (p & 31) * 16) = zv;
    if (tid < 16) *(LAS v4u*)(SHl - UPITCH + tid * 16) = zv;
    bf16x8 Bf[8];
#pragma unroll
    for (int ks = 0; ks < 8; ++ks) Bf[ks] = *(const bf16x8*)(TWS + ((size_t)(g * 128 + 16 * wid + fr)) * 256 + 32 * ks + 8 * fq);
    LDS_WAIT(); __syncthreads(); DBGS(0);
    {
        for (int mt = 0; mt < 9; ++mt) {
            bf16x8 uf[8];
#pragma unroll
            for (int ks = 0; ks < 8; ++ks) uf[ks] = *(const LAS bf16x8*)(Ul + (16 * mt + fr) * UPITCH + (32 * ks + 8 * fq) * 2);
            __builtin_amdgcn_sched_barrier(0);
            f32x4 a = {0.f, 0.f, 0.f, 0.f}, a2 = {0.f, 0.f, 0.f, 0.f};
#pragma unroll
            for (int ks = 0; ks < 8; ks += 2) { a = __builtin_amdgcn_mfma_f32_16x16x32_bf16(Bf[ks], uf[ks], a, 0, 0, 0); a2 = __builtin_amdgcn_mfma_f32_16x16x32_bf16(Bf[ks + 1], uf[ks + 1], a2, 0, 0, 0); }
            *(LAS f32x4*)(SHl + (16 * mt + fr) * UPITCH + (16 * wid + 4 * fq) * 4) = a + a2;
            __builtin_amdgcn_sched_barrier(0);
        }
    }
    bf16x8 Bt[2][8], By[2][4];
#pragma unroll
    for (int jj = 0; jj < 2; ++jj) { const size_t row = (size_t)(g * 256 + 16 * (2 * wid + jj) + fr);
#pragma unroll
        for (int ks = 0; ks < 8; ++ks) Bt[jj][ks] = *(const bf16x8*)(TTOEP + row * 256 + 32 * ks + 8 * fq);
#pragma unroll
        for (int ks = 0; ks < 4; ++ks) By[jj][ks] = *(const bf16x8*)(TWY + row * 128 + 32 * ks + 8 * fq); }
    LDS_WAIT(); __syncthreads(); DBGS(1);
    {
        const int n = lane, c0 = 16 * wid, nc = (wid == 7) ? 17 : 16;
        const f32x4 sm = *(const f32x4*)(SMT + ((size_t)(l * NG + g) * 64 + n) * 8 + 4);
        const float a16r = sm.x, a16i = sm.y;
        LAS float* Eseg = (LAS float*)(lds + 153600);
        float hr = 0.f, hi = 0.f;
        for (int j0 = 0; j0 < 16; j0 += 4) {
            float sr[4], si[4];
#pragma unroll
            for (int j = 0; j < 4; ++j) { sr[j] = *(const LAS float*)(SHl + (c0 + j0 + j) * UPITCH + n * 4); si[j] = *(const LAS float*)(SHl + (c0 + j0 + j) * UPITCH + (64 + n) * 4); }
            __builtin_amdgcn_sched_barrier(0);
#pragma unroll
            for (int j = 0; j < 4; ++j) { const float nr = a16r * hr - a16i * hi + sr[j], ni = a16r * hi + a16i * hr + si[j]; hr = nr; hi = ni;
                *(LAS float*)(SHl + (c0 + j0 + j) * UPITCH + n * 4) = hr; *(LAS float*)(SHl + (c0 + j0 + j) * UPITCH + (64 + n) * 4) = hi; }
        }
        if (nc == 17) { const float sr = *(const LAS float*)(SHl + 128 * UPITCH + n * 4), si = *(const LAS float*)(SHl + 128 * UPITCH + (64 + n) * 4);
            const float nr = a16r * hr - a16i * hi + sr, ni = a16r * hi + a16i * hr + si; hr = nr; hi = ni;
            *(LAS float*)(SHl + 128 * UPITCH + n * 4) = hr; *(LAS float*)(SHl + 128 * UPITCH + (64 + n) * 4) = hi; }
        Eseg[wid * 128 + n] = hr; Eseg[wid * 128 + 64 + n] = hi;
        LDS_WAIT(); __syncthreads();
        float p16r = a16r, p16i = a16i;
#pragma unroll
        for (int q = 0; q < 4; ++q) { const float t = p16r * p16r - p16i * p16i; p16i = 2.f * p16r * p16i; p16r = t; }
        float er[7], ei[7];
#pragma unroll
        for (int v = 0; v < 7; ++v) { er[v] = Eseg[v * 128 + n]; ei[v] = Eseg[v * 128 + 64 + n]; }
        float tr = 0.f, ti = 0.f;
#pragma unroll
        for (int v = 0; v < 7; ++v) if (v < wid) { const float nr = p16r * tr - p16i * ti + er[v], ni = p16r * ti + p16i * tr + ei[v]; tr = nr; ti = ni; }
        float pr = a16r, pi = a16i;
        for (int j0 = 0; j0 < 16; j0 += 4) {
            float sr[4], si[4];
#pragma unroll
            for (int j = 0; j < 4; ++j) { sr[j] = *(const LAS float*)(SHl + (c0 + j0 + j) * UPITCH + n * 4); si[j] = *(const LAS float*)(SHl + (c0 + j0 + j) * UPITCH + (64 + n) * 4); }
            __builtin_amdgcn_sched_barrier(0);
#pragma unroll
            for (int j = 0; j < 4; ++j) { hr = sr[j] + (pr * tr - pi * ti); hi = si[j] + (pr * ti + pi * tr);
                *(LAS unsigned short*)(SHl + (c0 + j0 + j) * UPITCH + n * 2) = (unsigned short)f2bf(hr);
                *(LAS unsigned short*)(SHl + (c0 + j0 + j) * UPITCH + (64 + n) * 2) = (unsigned short)f2bf(hi);
                const float t = pr * a16r - pi * a16i; pi = pr * a16i + pi * a16r; pr = t; }
        }
        if (nc == 17) { const float sr = *(const LAS float*)(SHl + 128 * UPITCH + n * 4), si = *(const LAS float*)(SHl + 128 * UPITCH + (64 + n) * 4);
            hr = sr + (pr * tr - pi * ti); hi = si + (pr * ti + pi * tr);
            *(LAS unsigned short*)(SHl + 128 * UPITCH + n * 2) = (unsigned short)f2bf(hr); *(LAS unsigned short*)(SHl + 128 * UPITCH + (64 + n) * 2) = (unsigned short)f2bf(hi);
            re_p[((size_t)(b * NG + g)) * 64 + n] = hr; im_p[((size_t)(b * NG + g)) * 64 + n] = hi; }
    }
    LDS_WAIT(); __syncthreads(); DBGS(2);
    {
        for (int mt = 0; mt < 9; ++mt) {
            bf16x8 uf[8], hf[4];
#pragma unroll
            for (int ks = 0; ks < 8; ++ks) uf[ks] = *(const LAS bf16x8*)(Ul + (16 * mt + fr) * UPITCH + (32 * ks + 8 * fq) * 2);
#pragma unroll
            for (int ks = 0; ks < 4; ++ks) hf[ks] = *(const LAS bf16x8*)(SHl - UPITCH + (16 * mt + fr) * UPITCH + (32 * ks + 8 * fq) * 2);
            __builtin_amdgcn_sched_barrier(0);
            f32x4 a0 = {0.f, 0.f, 0.f, 0.f}, a1 = {0.f, 0.f, 0.f, 0.f};
#pragma unroll
            for (int ks = 0; ks < 8; ++ks) { a0 = __builtin_amdgcn_mfma_f32_16x16x32_bf16(Bt[0][ks], uf[ks], a0, 0, 0, 0); a1 = __builtin_amdgcn_mfma_f32_16x16x32_bf16(Bt[1][ks], uf[ks], a1, 0, 0, 0); }
#pragma unroll
            for (int ks = 0; ks < 4; ++ks) { a0 = __builtin_amdgcn_mfma_f32_16x16x32_bf16(By[0][ks], hf[ks], a0, 0, 0, 0); a1 = __builtin_amdgcn_mfma_f32_16x16x32_bf16(By[1][ks], hf[ks], a1, 0, 0, 0); }
            __builtin_amdgcn_sched_barrier(0);
            const int c = 16 * mt + fr;
            if (c < 129) {
                const size_t row = (size_t)(b * LSEQ + 16 * c + 2 * wid);
                const f32x2 e0 = gelu2(pr2(a0, 0)), e1 = gelu2(pr2(a0, 1)), e2 = gelu2(pr2(a1, 0)), e3 = gelu2(pr2(a1, 1));
                v2u o0, o1; o0.x = pg8::cvt_pk_bf16(e0.x, e0.y); o0.y = pg8::cvt_pk_bf16(e1.x, e1.y);
                o1.x = pg8::cvt_pk_bf16(e2.x, e2.y); o1.y = pg8::cvt_pk_bf16(e3.x, e3.y);
                *(v2u*)(YS + row * SW + 16 * g + 4 * fq) = o0; *(v2u*)(YS + (row + 1) * SW + 16 * g + 4 * fq) = o1;
            }
        }
    }
    __syncthreads(); DBGS(3);
}

__device__ __forceinline__ void ssm_sample_item(int lane, int l, int bs, int g, const bf16* US, bf16* YS, const float* SMT,
        const float* B_re, const float* B_im, const float* C_re, const float* C_im, const float* Dsk, const float* st_re, const float* st_im, float* re_s, float* im_s) {
    const int n = lane, lg = l * NG + g;
    const f32x4 sm = *(const f32x4*)(SMT + ((size_t)lg * 64 + n) * 8);
    const bf16* up = US + ((size_t)(MP + bs)) * SW + 16 * g; const v4u u0 = *(const v4u*)up, u1 = *(const v4u*)(up + 8);
    const float* brp = B_re + ((size_t)lg * 64 + n) * 16; const float* bip = B_im + ((size_t)lg * 64 + n) * 16;
    f32x4 br[4], bi[4];
#pragma unroll
    for (int q4 = 0; q4 < 4; ++q4) { br[q4] = *(const f32x4*)(brp + 4 * q4); bi[q4] = *(const f32x4*)(bip + 4 * q4); }
    const size_t so = ((size_t)((l * NS + bs) * NG + g)) * 64 + n;
    const float h0r = st_re[so], h0i = st_im[so];
    float cr[16], ci[16];
#pragma unroll
    for (int p = 0; p < 16; ++p) { cr[p] = C_re[((size_t)lg * 16 + p) * 64 + n]; ci[p] = C_im[((size_t)lg * 16 + p) * 64 + n]; }
    const int pme = ((lane >> 5) & 1) * 8 + ((lane >> 4) & 1) * 4 + ((lane >> 3) & 1) * 2 + ((lane >> 2) & 1);
    const float dme = Dsk[l * SW + 16 * g + pme]; const float ume = bflo((unsigned)up[pme]);
    __builtin_amdgcn_sched_barrier(0);
    float uu[16]; { float t8[8]; unpack8(u0, t8);
#pragma unroll
      for (int e = 0; e < 8; ++e) uu[e] = t8[e];
      unpack8(u1, t8);
#pragma unroll
      for (int e = 0; e < 8; ++e) uu[8 + e] = t8[e]; }
    float sr = 0.f, si = 0.f;
#pragma unroll
    for (int q4 = 0; q4 < 4; ++q4)
#pragma unroll
        for (int j = 0; j < 4; ++j) { sr += br[q4][j] * uu[4 * q4 + j]; si += bi[q4][j] * uu[4 * q4 + j]; }
    const float hr = sm.x * h0r - sm.y * h0i + (sm.z * sr - sm.w * si), hi = sm.x * h0i + sm.y * h0r + (sm.z * si + sm.w * sr);
    re_s[so] = hr; im_s[so] = hi;
    float v[16];
#pragma unroll
    for (int p = 0; p < 16; ++p) v[p] = cr[p] * hr - ci[p] * hi;
    { const bool hi32 = (lane & 32) != 0;
#pragma unroll
      for (int i = 0; i < 8; ++i) { const float snd = hi32 ? v[i] : v[8 + i], keep = hi32 ? v[8 + i] : v[i]; v[i] = keep + __shfl_xor(snd, 32); } }
    { const bool hb = (lane & 16) != 0;
#pragma unroll
      for (int i = 0; i < 4; ++i) { const float snd = hb ? v[i] : v[4 + i], keep = hb ? v[4 + i] : v[i]; v[i] = keep + __shfl_xor(snd, 16); } }
    { const bool hb = (lane & 8) != 0;
#pragma unroll
      for (int i = 0; i < 2; ++i) { const float snd = hb ? v[i] : v[2 + i], keep = hb ? v[2 + i] : v[i]; v[i] = keep + __shfl_xor(snd, 8); } }
    { const bool hb = (lane & 4) != 0; const float snd = hb ? v[0] : v[1], keep = hb ? v[1] : v[0]; v[0] = keep + __shfl_xor(snd, 4); }
    v[0] += __shfl_xor(v[0], 2); v[0] += __shfl_xor(v[0], 1);
    if ((lane & 3) == 0) YS[((size_t)(MP + bs)) * SW + 16 * g + pme] = (bf16)f2bf(gelu_t(v[0] + dme * ume));
}

constexpr int PPITCH = 272;
__device__ __forceinline__ void pool_unit(LAS unsigned char* lds, int tid, int pm, int grp, const bf16* UP, bf16* GP, const bf16* WPOOL, const float* hs) {
    const int wid = __builtin_amdgcn_readfirstlane(tid >> 6), lane = tid & 63, wr = wid >> 2, wc = wid & 3, fr = lane & 15, fq = lane >> 4;
    LAS unsigned char* Ut = lds; LAS unsigned char* Dt = lds + 73728;
    const int r0 = pm * 256, w = 2 << grp;
    __syncthreads();
    unsigned z_ = 0u; asm volatile("" : "+v"(z_)); const v4u zv = {z_, z_, z_, z_};
    bf16x8 Bf[2][2][4]; v4u gwa[2][4][2];
#pragma unroll
    for (int bj = 0; bj < 2; ++bj)
#pragma unroll
        for (int n = 0; n < 2; ++n) { const int prow = 128 * bj + 32 * wc + 8 * (fr >> 2) + 4 * n + (fr & 3);
#pragma unroll
            for (int ks = 0; ks < 4; ++ks) Bf[bj][n][ks] = *(const bf16x8*)(WPOOL + ((size_t)(grp * 256 + prow)) * 128 + 32 * ks + 8 * fq); }
#pragma unroll
    for (int ai = 0; ai < 2; ++ai)
#pragma unroll
        for (int m = 0; m < 4; ++m)
#pragma unroll
            for (int bj = 0; bj < 2; ++bj) gwa[ai][m][bj] = *(const v4u*)(GP + (size_t)(r0 + 128 * ai + 64 * wr + 16 * m + fr) * D + 256 * grp + 128 * bj + 32 * wc + 8 * fq);
    {
        v4u uv[9];
#pragma unroll
        for (int i = 0; i < 9; ++i) { const int it = tid + 512 * i, rr = it >> 4, oct = it & 15, r = r0 - 15 + rr; uv[i] = zv;
            if (it < 271 * 16 && r >= 0) uv[i] = *(const v4u*)(UP + (size_t)r * PW + 128 * grp + 8 * oct); }
        __builtin_amdgcn_sched_barrier(0);
#pragma unroll
        for (int i = 0; i < 9; ++i) { const int it = tid + 512 * i, rr = it >> 4, oct = it & 15;
            if (it < 271 * 16) *(LAS v4u*)(Ut + rr * PPITCH + oct * 16) = uv[i]; }
    }
    LDS_WAIT(); __syncthreads();
    for (int it = tid; it < 4096; it += 512) {
        const int row = it >> 4, oct = it & 15, r = r0 + row;
        float self[8], sum[8], x[8]; float inv;
        unpack8(*(const LAS v4u*)(Ut + (row + 15) * PPITCH + oct * 16), self);
#pragma unroll
        for (int e = 0; e < 8; ++e) sum[e] = self[e];
        if (r < MP) { const int t = r % LSEQ; const int nav = (t + 1 < w) ? (t + 1) : w;
            for (int i = 1; i < nav; ++i) { unpack8(*(const LAS v4u*)(Ut + (row + 15 - i) * PPITCH + oct * 16), x);
#pragma unroll
                for (int e = 0; e < 8; ++e) sum[e] += x[e]; }
            inv = 1.0f / (float)nav;
        } else { const float* h = hs + ((size_t)(r - MP)) * PW + 128 * grp + 8 * oct; const f32x4 a = *(const f32x4*)h, c = *(const f32x4*)(h + 4);
#pragma unroll
            for (int e = 0; e < 4; ++e) { sum[e] += a[e]; sum[4 + e] += c[e]; }
            inv = 1.0f / (float)w;
        }
#pragma unroll
        for (int e = 0; e < 8; ++e) x[e] = sum[e] * inv - self[e];
        *(LAS v4u*)(Dt + row * PPITCH + oct * 16) = pack8(x);
    }
    LDS_WAIT(); __syncthreads();
#pragma unroll
    for (int ai = 0; ai < 2; ++ai)
#pragma unroll
        for (int m = 0; m < 4; ++m) {
            f32x4 a[2][2];
#pragma unroll
            for (int bj = 0; bj < 2; ++bj)
#pragma unroll
                for (int n = 0; n < 2; ++n) a[bj][n] = (f32x4){0.f, 0.f, 0.f, 0.f};
            const int row = 128 * ai + 64 * wr + 16 * m + fr, r = r0 + row;
            bf16x8 df[4];
#pragma unroll
            for (int ks = 0; ks < 4; ++ks) df[ks] = *(const LAS bf16x8*)(Dt + row * PPITCH + (32 * ks + 8 * fq) * 2);
            __builtin_amdgcn_sched_barrier(0);
#pragma unroll
            for (int ks = 0; ks < 4; ++ks)
#pragma unroll
                for (int bj = 0; bj < 2; ++bj)
#pragma unroll
                    for (int n = 0; n < 2; ++n) a[bj][n] = __builtin_amdgcn_mfma_f32_16x16x32_bf16(Bf[bj][n][ks], df[ks], a[bj][n], 0, 0, 0);
#pragma unroll
            for (int bj = 0; bj < 2; ++bj) { bf16* p = GP + (size_t)r * D + 256 * grp + 128 * bj + 32 * wc + 8 * fq; float gv[8], o[8]; unpack8(gwa[ai][m][bj], gv);
#pragma unroll
                for (int n = 0; n < 2; ++n)
#pragma unroll
                    for (int j = 0; j < 4; ++j) o[4 * n + j] = gv[4 * n + j] * a[bj][n][j];
                *(v4u*)p = pack8(o); }
        }
}

__device__ __forceinline__ void pool_mini(int lane, int rbase, int grp, const bf16* UP, bf16* GP, const bf16* WPOOL, const float* hs) {
    const int fr = lane & 15, fq = lane >> 4, r = rbase + fr, w = 2 << grp;
    bf16x8 df[4];
    {
        const int col0 = 128 * grp + 8 * fq;
        float self[4][8], sum[4][8]; float inv;
#pragma unroll
        for (int ks = 0; ks < 4; ++ks) { unpack8(*(const v4u*)(UP + (size_t)r * PW + col0 + 32 * ks), self[ks]);
#pragma unroll
            for (int e = 0; e < 8; ++e) sum[ks][e] = self[ks][e]; }
        if (r < MP) { const int t = r % LSEQ; const int nav = (t + 1 < w) ? (t + 1) : w;
#pragma unroll 3
            for (int i = 1; i < w; ++i) {
                v4u xv[4];
#pragma unroll
                for (int ks = 0; ks < 4; ++ks) xv[ks] = *(const v4u*)(UP + (size_t)(r - i) * PW + col0 + 32 * ks);
                __builtin_amdgcn_sched_barrier(0);
                const float mk = (i < nav) ? 1.0f : 0.0f;
#pragma unroll
                for (int ks = 0; ks < 4; ++ks) { float x[8]; unpack8(xv[ks], x);
#pragma unroll
                    for (int e = 0; e < 8; ++e) sum[ks][e] += mk * x[e]; }
            }
            inv = 1.0f / (float)nav;
        } else {
#pragma unroll
            for (int ks = 0; ks < 4; ++ks) { const float* h = hs + ((size_t)(r - MP)) * PW + col0 + 32 * ks; const f32x4 a = *(const f32x4*)h, c = *(const f32x4*)(h + 4);
#pragma unroll
                for (int e = 0; e < 4; ++e) { sum[ks][e] += a[e]; sum[ks][4 + e] += c[e]; } }
            inv = 1.0f / (float)w; }
#pragma unroll
        for (int ks = 0; ks < 4; ++ks) { float x[8];
#pragma unroll
            for (int e = 0; e < 8; ++e) x[e] = sum[ks][e] * inv - self[ks][e];
            const v4u pk = pack8(x); df[ks] = __builtin_bit_cast(bf16x8, pk); }
    }
    for (int nt = 0; nt < 16; nt += 2) {
        bf16x8 bw[2][4];
#pragma unroll
        for (int q = 0; q < 2; ++q)
#pragma unroll
            for (int ks = 0; ks < 4; ++ks) bw[q][ks] = *(const bf16x8*)(WPOOL + ((size_t)(grp * 256 + 16 * (nt + q) + fr)) * 128 + 32 * ks + 8 * fq);
#pragma unroll
        for (int q = 0; q < 2; ++q) {
            f32x4 a = {0.f, 0.f, 0.f, 0.f};
#pragma unroll
            for (int ks = 0; ks < 4; ++ks) a = __builtin_amdgcn_mfma_f32_16x16x32_bf16(bw[q][ks], df[ks], a, 0, 0, 0);
            bf16* p = GP + (size_t)r * D + 256 * grp + 16 * (nt + q) + 4 * fq; const v2u gw = *(const v2u*)p;
            v2u o; o.x = pg8::cvt_pk_bf16(bflo(gw.x) * a[0], bfhi(gw.x) * a[1]); o.y = pg8::cvt_pk_bf16(bflo(gw.y) * a[2], bfhi(gw.y) * a[3]);
            *(v2u*)p = o;
        }
    }
}

__device__ __forceinline__ void act_fixup(int tid, int pm, bf16* ACT, const float* cw, const float* cb, const float* Gtop, const float* Vtop, const float* Gbot) {
    for (int it = tid; it < 2 * (DFF / 4); it += 512) {
        const int e = it / (DFF / 4), c4 = (it % (DFF / 4)) * 4, r = pm * 256 + e, t = r % LSEQ;
        const f32x4 g0 = *(const f32x4*)(Gtop + ((size_t)(pm * 2 + e)) * DFF + c4), vv = *(const f32x4*)(Vtop + ((size_t)(pm * 2 + e)) * DFF + c4);
        const f32x4 b1 = *(const f32x4*)(Gbot + ((size_t)((pm - 1) * 2 + 1)) * DFF + c4), b0 = *(const f32x4*)(Gbot + ((size_t)((pm - 1) * 2 + 0)) * DFF + c4), t0 = *(const f32x4*)(Gtop + ((size_t)(pm * 2)) * DFF + c4);
        f32x4 g1 = (e == 1) ? t0 : b1, g2 = (e == 1) ? b1 : b0;
        if (t == 0) g1 = (f32x4){0.f, 0.f, 0.f, 0.f};
        if (t <= 1) g2 = (f32x4){0.f, 0.f, 0.f, 0.f};
        const f32x4 w0 = *(const f32x4*)(cw + c4), w1 = *(const f32x4*)(cw + DFF + c4), w2 = *(const f32x4*)(cw + 2 * DFF + c4), bb = *(const f32x4*)(cb + c4);
        float o[4];
#pragma unroll
        for (int j = 0; j < 4; ++j) o[j] = gelu_t(bb[j] + w0[j] * g2[j] + w1[j] * g1[j] + w2[j] * g0[j]) * vv[j];
        v2u w; w.x = pg8::cvt_pk_bf16(o[0], o[1]); w.y = pg8::cvt_pk_bf16(o[2], o[3]);
        *(v2u*)(ACT + (size_t)r * DFF + c4) = w;
    }
}

constexpr size_t O_YP = 0, O_YS = O_YP + (size_t)NB * SEQ * D, O_POOLP = O_YS + (size_t)NS * D, O_REP = O_POOLP + (size_t)DEPTH * NB * PHIST * PW,
                 O_IMP = O_REP + (size_t)DEPTH * NB * NG * NST, O_CONVP = O_IMP + (size_t)DEPTH * NB * NG * NST, O_POOLS = O_CONVP + (size_t)DEPTH * NB * 2 * DFF,
                 O_RES = O_POOLS + (size_t)DEPTH * NS * PHIST * PW, O_IMS = O_RES + (size_t)DEPTH * NS * NG * NST, O_CONVS = O_IMS + (size_t)DEPTH * NS * NG * NST,
                 O_END = O_CONVS + (size_t)DEPTH * NS * 2 * DFF;
static_assert(O_END == 21643264, "output size");

enum { I_XP = 0, I_XS, I_SPOOL, I_SRE, I_SIM, I_SCONV, I_META, I_N1G, I_WIN, I_POOLW, I_POOLSC, I_ARE, I_AIM, I_LOGDT, I_BRE, I_BIM, I_CRE, I_CIM, I_DSK, I_WGLU, I_WOUT, I_N2G, I_WUP, I_CONVW, I_CONVB, I_WDOWN, I_NFG, N_IN };

struct Args { const float* in[N_IN]; float* out; unsigned char* ws; unsigned long long pad; };

constexpr int NWAVES = 8;
__global__ void __launch_bounds__(NWAVES * 64, 2) mk_fwd(Args args) {
    extern __shared__ __attribute__((aligned(16))) unsigned char lds_raw[];
    LAS unsigned char* lds = (LAS unsigned char*)lds_raw;
    volatile LAS unsigned* MISC = (volatile LAS unsigned*)(lds + MISC_OFF);
    const int tid = threadIdx.x, lane = tid & 63, wave = __builtin_amdgcn_readfirstlane(tid >> 6);
    const int G = gridDim.x, bx = blockIdx.x;
    const char __attribute__((address_space(4)))* kargs = (const char __attribute__((address_space(4)))*)__builtin_amdgcn_kernarg_segment_ptr();
#define INP(i) ([&]() { const float GAS* p_; asm volatile("s_load_dwordx2 %0, %1, %2\n\ts_waitcnt lgkmcnt(0)" : "=s"(p_) : "s"(kargs), "i"(8 * (i)) : "memory"); return (const float*)p_; }())
    unsigned char* ws = args.ws; float* out = args.out;
    for (int u = tid; u < (LDS_BYTES - LDSCTL_OFF) / 4; u += NWAVES * 64) ((LAS unsigned*)(lds + LDSCTL_OFF))[u] = 0u;
    __syncthreads();
    XcdBarrier bar = xcd_barrier_post((unsigned*)(ws + WS_CTL) + CW_BAR, MISC + 8);
#ifdef TS_I
    int n_stamp_ = 0;
#define STAMP() do { if (threadIdx.x == 0) { const unsigned long long t_ = __builtin_amdgcn_s_memrealtime(); MISC[16 + 2 * n_stamp_] = (unsigned)t_; MISC[17 + 2 * n_stamp_] = (unsigned)(t_ >> 32); } ++n_stamp_; } while (0)
#else
#define STAMP() do {} while (0)
#endif
#ifdef BAR_DELAY
#define GRID_BAR() do { xcd_barrier(bar); { const unsigned long long t0_ = __builtin_amdgcn_s_memrealtime(); while (__builtin_amdgcn_s_memrealtime() - t0_ < BAR_DELAY) __builtin_amdgcn_s_sleep(8); } __syncthreads(); } while (0)
#else
#ifdef DOUBLE_BAR
#define GRID_BAR() do { xcd_barrier(bar); xcd_barrier(bar); STAMP(); } while (0)
#else
#define GRID_BAR() do { xcd_barrier(bar); STAMP(); } while (0)
#endif
#endif
#ifdef GEMM_DBG
#define DBGP(c) (((c) == GEMM_DBG && l == 0) ? (MISC + 50) : (volatile LAS unsigned*)nullptr)
#else
#define DBGP(c) ((volatile LAS unsigned*)nullptr)
#endif
#define OPAQUE_TID() int ptid = threadIdx.x; asm volatile("" : "+v"(ptid)); const int plane = ptid & 63; (void)plane

    STAMP();
    float* RS = (float*)(ws + WS_RS); float* RSX = (float*)(ws + WS_RSX); float* SMT = (float*)(ws + WS_SM);
    float* Gtop = (float*)(ws + WS_GTOP); float* Vtop = (float*)(ws + WS_VTOP); float* Gbot = (float*)(ws + WS_GBOT);
    bf16* XB = (bf16*)(ws + WS_XB); bf16* YSB = (bf16*)(ws + WS_YS);
    bf16* UPB = (bf16*)(ws + WS_UP); bf16* USB = (bf16*)(ws + WS_US); bf16* GP = (bf16*)(ws + WS_GP); bf16* GS = (bf16*)(ws + WS_GS); bf16* ACT = (bf16*)(ws + WS_ACT);
    const int gw = bx * NWAVES + wave, NGW = G * NWAVES;

#ifndef PH_MASK
#define PH_MASK 0xFFFF
#endif
#define PH(k) ((PH_MASK >> (k)) & 1)
    constexpr int I_IN = (D / 64) * (NIN / 64), I_GLU = (SW / 64) * (2 * D / 64), I_OUT = (D / 64) * (D / 64), I_UP = (D / 64) * (NUP / 64), I_DOWN = (DFF / 64) * (D / 64), I_PL = (128 / 64) * (256 / 64);
    constexpr int NITEMS = I_IN + I_GLU + I_OUT + I_UP + I_DOWN + 4 * I_PL;
    constexpr int NWG_E = (M / 256) * (NUP / 256);
    const int e_rem = NWG_E % G, e_idle = G - e_rem;
    const bool defer_l1 = e_rem != 0 && e_idle * 4 >= G;
#ifdef DBG_P
    unsigned long long tp_ = __builtin_amdgcn_s_memrealtime();
#define DBGT(i) do { __syncthreads(); const unsigned long long t_ = __builtin_amdgcn_s_memrealtime(); if (threadIdx.x == 0) MISC[54 + (i)] = (unsigned)(t_ - tp_); tp_ = t_; } while (0)
#else
#define DBGT(i) do {} while (0)
#endif
#pragma unroll 1
    for (int pass = 0; pass < 2; ++pass) {
    if (PH(1) && ((pass == 0) == (((bx >> 3) & 1) != 0))) {
        OPAQUE_TID();
        for (int u = bx; u < DEPTH * NG * 4; u += G) { const int l = u / (NG * 4), v = u % (NG * 4); bf16* Tl = (bf16*)(ws + WS_T0 + (size_t)l * WS_TSTRIDE);
            ssm_tables(lds, ptid, l, v >> 2, v & 3, INP(I_ARE), INP(I_AIM), INP(I_LOGDT), INP(I_BRE), INP(I_BIM), INP(I_CRE), INP(I_CIM), INP(I_DSK), Tl + TO_WS / 2, Tl + TO_TOEP / 2, Tl + TO_WY / 2, SMT); }
        __syncthreads();
        DBGT(3);
    }
    if (pass != 0) break;
    if (PH(0)) {
    OPAQUE_TID(); const int pgw = bx * NWAVES + __builtin_amdgcn_readfirstlane(ptid >> 6);
    for (int m = pgw; m < M; m += NGW) {
        const float* src;
        if (m < MP) { const int b = m / LSEQ, t = m - b * LSEQ; src = (t < NMETA) ? INP(I_META) + (size_t)t * D : INP(I_XP) + ((size_t)(b * SEQ + t - NMETA)) * D; }
        else src = INP(I_XS) + (size_t)(m - MP) * D;
        const f32x4* s4 = (const f32x4*)src + plane; f32x4 v[4]; float ss = 0.f;
#pragma unroll
        for (int j = 0; j < 4; ++j) v[j] = __builtin_nontemporal_load(s4 + 64 * j);
        unsigned long long* o8 = (unsigned long long*)(XB + (size_t)m * D) + plane;
#pragma unroll
        for (int j = 0; j < 4; ++j) { const unsigned lo = pk2(v[j].x, v[j].y), hi = pk2(v[j].z, v[j].w); o8[64 * j] = (unsigned long long)lo | ((unsigned long long)hi << 32);
            const float a0 = bflo(lo), a1 = bfhi(lo), a2 = bflo(hi), a3 = bfhi(hi); ss += (a0 * a0 + a1 * a1) + (a2 * a2 + a3 * a3); }
        ss = wave_sum(ss);
        if (m < MMAIN) { if (plane < 16) RS[(size_t)m * 16 + plane] = (plane == 0) ? ss : 0.f; } else if (plane < 32) RSX[(size_t)(m - MMAIN) * 32 + plane] = (plane == 0) ? ss : 0.f;
    }
    DBGT(0);
    {
        const int gt = bx * (NWAVES * 64) + ptid, NGT = G * NWAVES * 64;
        float* HS = (float*)(ws + WS_HS);
        for (int i = gt; i < DEPTH * NS * (PW / 4); i += NGT) { const int lb = i / (PW / 4), c4 = i % (PW / 4), w = 2 << (c4 >> 5); f32x4 s = {0.f, 0.f, 0.f, 0.f};
            const float* hp = INP(I_SPOOL) + ((size_t)(lb * PHIST + PHIST)) * PW + 4 * c4;
#pragma unroll
            for (int j0 = 1; j0 < 16; j0 += 5) { if (j0 >= w) break; f32x4 hv[5];
#pragma unroll
                for (int jj = 0; jj < 5; ++jj) { const int j = j0 + jj; hv[jj] = __builtin_nontemporal_load((const f32x4*)(hp - (size_t)((j < w) ? j : 1) * PW)); }
#pragma unroll
                for (int jj = 0; jj < 5; ++jj) { const int j = j0 + jj; if (j < w) s += hv[jj]; } }
            *(f32x4*)(HS + (size_t)lb * PW + 4 * c4) = s; }
#define STATE_COPIES(gt_, ngt_) do { \
        for (int i = (gt_); i < DEPTH * NS * 14 * (PW / 4); i += (ngt_)) { const int lb = i / (14 * (PW / 4)), rem = i % (14 * (PW / 4)), rr = rem / (PW / 4), c4 = rem % (PW / 4); \
            *(f32x4*)(out + O_POOLS + ((size_t)(lb * PHIST + rr)) * PW + 4 * c4) = __builtin_nontemporal_load((const f32x4*)(INP(I_SPOOL) + ((size_t)(lb * PHIST + rr + 1)) * PW + 4 * c4)); } \
        for (int i = (gt_); i < DEPTH * NS * (DFF / 4); i += (ngt_)) { const int lb = i / (DFF / 4), c4 = i % (DFF / 4); \
            *(f32x4*)(out + O_CONVS + ((size_t)(lb * 2)) * DFF + 4 * c4) = __builtin_nontemporal_load((const f32x4*)(INP(I_SCONV) + ((size_t)(lb * 2 + 1)) * DFF + 4 * c4)); } } while (0)
        if (!defer_l1) STATE_COPIES(gt, NGT);
    }
    }
    DBGT(1);
    if (PH(1)) {
        OPAQUE_TID();
        LAS float* scr = (LAS float*)(lds + wave * TR_BYTES);
#define PREP_ITEM(l_, r_) do { const int l = (l_); int r = (r_); bf16* Wl = (bf16*)(ws + WS_W0 + (size_t)l * WS_WSTRIDE); \
            if (r < I_IN) { transpose_item(INP(I_WIN) + (size_t)l * D * NIN, D, NIN, Wl + WO_IN / 2, scr, r, plane, INP(I_N1G) + l * D, nullptr, 0); break; } r -= I_IN; \
            if (r < I_GLU) { transpose_item(INP(I_WGLU) + (size_t)l * SW * 2 * D, SW, 2 * D, Wl + WO_GLU / 2, scr, r, plane, nullptr, nullptr, 1); break; } r -= I_GLU; \
            if (r < I_OUT) { transpose_item(INP(I_WOUT) + (size_t)l * D * D, D, D, Wl + WO_OUT / 2, scr, r, plane, nullptr, nullptr, 0); break; } r -= I_OUT; \
            if (r < I_UP) { transpose_item(INP(I_WUP) + (size_t)l * D * NUP, D, NUP, Wl + WO_UP / 2, scr, r, plane, INP(I_N2G) + l * D, nullptr, 1); break; } r -= I_UP; \
            if (r < 4 * I_PL) { const int grp = r / I_PL; transpose_item(INP(I_POOLW) + ((size_t)(l * 4 + grp)) * 128 * 256, 128, 256, Wl + WO_POOL / 2 + (size_t)grp * 256 * 128, scr, r % I_PL, plane, nullptr, INP(I_POOLSC) + l * D + 256 * grp, 0); break; } r -= 4 * I_PL; \
            transpose_item(INP(I_WDOWN) + (size_t)l * DFF * D, DFF, D, Wl + WO_DOWN / 2, scr, r, plane, nullptr, nullptr, 0); } while (0)
        for (int it = gw; it < (defer_l1 ? NITEMS - I_DOWN : DEPTH * NITEMS); it += NGW) { const int l_ = it / NITEMS; PREP_ITEM(l_, it - l_ * NITEMS); }
        DBGT(2);
    }
    }
    GRID_BAR();

#pragma unroll 1
    for (int l = 0; l < DEPTH; ++l) {
        bf16* Wl = (bf16*)(ws + WS_W0 + (size_t)l * WS_WSTRIDE); bf16* Tl = (bf16*)(ws + WS_T0 + (size_t)l * WS_TSTRIDE);
        bf16* WIN = Wl + WO_IN / 2; bf16* WGLU = Wl + WO_GLU / 2; bf16* WOUT = Wl + WO_OUT / 2; bf16* WUP = Wl + WO_UP / 2; bf16* WDOWN = Wl + WO_DOWN / 2; bf16* WPOOL = Wl + WO_POOL / 2;
        bf16* TWS = Tl + TO_WS / 2; bf16* TTOEP = Tl + TO_TOEP / 2; bf16* TWY = Tl + TO_WY / 2;

        if (PH(2))
        {
            pg8::Gemm g{XB, WIN, MMAIN, NIN, D}; pg8::StaticOrder S; S.init(MMAIN, NIN, G, bx); S.strip_base = MMAIN;
            { OPAQUE_TID(); fill_rstd((LAS float*)(lds + RSTD_OFF), RS, RSX, S, ptid); }
            EpiIn E{UPB, USB, GP, GS, (const LAS float*)(lds + RSTD_OFF), out + O_POOLP + (size_t)l * NB * PHIST * PW, out + O_POOLS + (size_t)l * NS * PHIST * PW};
            pg8::gemm_phase<EpiIn, pg8::StaticOrder, true>(lds, lds + XS_OFF, g, S, E);
        }
        GRID_BAR();

        if (PH(3))
        {
            OPAQUE_TID();
            SampleArgs sa{nullptr, nullptr, nullptr, nullptr, nullptr, nullptr, nullptr, nullptr, nullptr, -1, 0};
#ifdef DBG_B
            const unsigned long long tb0_ = __builtin_amdgcn_s_memrealtime();
#endif
            constexpr int NPU = (MMAIN / 256) * 4;
            if (bx & 1) for (int u = bx; u < NPU; u += G) pool_unit(lds, ptid, u >> 2, u & 3, UPB, GP, WPOOL, (const float*)(ws + WS_HS) + (size_t)l * NS * PW);
            for (int u = bx; u < NB * NG; u += G)
                ssm_unit(lds, ptid, l, u >> 5, 4 * (u & 7) + ((u >> 3) & 3), USB, YSB,     TWS, TTOEP, TWY, SMT, out + O_REP + (size_t)l * NB * NG * NST, out + O_IMP + (size_t)l * NB * NG * NST, sa, (l == 0) ? (MISC + 54) : (volatile LAS unsigned*)nullptr);
#ifdef DBG_B
            __syncthreads(); const unsigned long long tb1_ = __builtin_amdgcn_s_memrealtime();
#endif
            if (!(bx & 1)) for (int u = bx; u < NPU; u += G) pool_unit(lds, ptid, u >> 2, u & 3, UPB, GP, WPOOL, (const float*)(ws + WS_HS) + (size_t)l * NS * PW);
            {
                const int pw_ = __builtin_amdgcn_readfirstlane(ptid >> 6);
                if (pw_ == 7) for (int mu = bx; mu < 64 * 4; mu += G) if ((mu & 3) == 0) { const int q = mu >> 2;
                    pool_mini(plane, MMAIN + 16 * (q >> 2), q & 3, UPB, GP, WPOOL, (const float*)(ws + WS_HS) + (size_t)l * NS * PW); }
            }
            {
                const int nx = NPU - G, skip = (nx > 0 && nx * 2 < G) ? nx : 0;
                if (bx >= skip) { const int pw_ = __builtin_amdgcn_readfirstlane(ptid >> 6);
                    for (int it = (bx - skip) * NWAVES + pw_; it < NS * NG; it += (G - skip) * NWAVES)
                        ssm_sample_item(plane, l, it >> 5, it & 31, USB, YSB, SMT, INP(I_BRE), INP(I_BIM), INP(I_CRE), INP(I_CIM), INP(I_DSK), INP(I_SRE), INP(I_SIM), out + O_RES, out + O_IMS); }
            }
#ifdef DBG_B
            __syncthreads(); if (l == 0 && threadIdx.x == 0) { const unsigned long long tb2_ = __builtin_amdgcn_s_memrealtime(); MISC[52] = (unsigned)(tb1_ - tb0_); MISC[53] = (unsigned)(tb2_ - tb1_); }
#endif
        }
        GRID_BAR();

        if (PH(4))
        {
            pg8::Gemm g{YSB, WGLU, MMAIN, 2 * D, SW}; pg8::StaticOrder S; S.init(MMAIN, 2 * D, G, bx); S.strip_base = MMAIN;
            EpiGlu E{GP, GS};
            pg8::gemm_phase<EpiGlu, pg8::StaticOrder, true>(lds, lds + XS_OFF, g, S, E);
        }
        GRID_BAR();

        if (PH(5))
        {
            pg8::Gemm g{GP, WOUT, M, D, D}; pg8::StaticOrder S; S.init(M, D, G, bx);
            EpiRes E{XB, RS, RSX};
            pg8::gemm_phase<EpiRes, pg8::StaticOrder, true>(lds, lds + XS_OFF, g, S, E);
        }
        GRID_BAR();

        if (PH(6))
        {
            pg8::Gemm g{XB, WUP, M, NUP, D}; pg8::StaticOrder S; S.init(M, NUP, G, bx);
            { OPAQUE_TID(); fill_rstd((LAS float*)(lds + RSTD_OFF), RS, RSX, S, ptid); }
            EpiUp E{ACT, (const LAS float*)(lds + RSTD_OFF), INP(I_CONVW) + (size_t)l * 3 * DFF, INP(I_CONVB) + (size_t)l * DFF, INP(I_SCONV) + (size_t)l * NS * 2 * DFF,
                    out + O_CONVP + (size_t)l * NB * 2 * DFF, out + O_CONVS + (size_t)l * NS * 2 * DFF, Gtop, Vtop, Gbot, (LAS float*)(lds + XCH_OFF), (LAS float*)(lds + PRM_OFF)};
            pg8::gemm_phase<EpiUp, pg8::StaticOrder, false>(lds, lds + XS_OFF, g, S, E);
            if (l == 1 && defer_l1 && bx >= e_rem) { OPAQUE_TID(); STATE_COPIES((bx - e_rem) * (NWAVES * 64) + ptid, e_idle * NWAVES * 64); }
            if (l == 0 && defer_l1 && bx >= e_rem) {
                OPAQUE_TID(); const int pw_ = __builtin_amdgcn_readfirstlane(ptid >> 6); LAS float* scr = (LAS float*)(lds + pw_ * TR_BYTES);
                for (int it = (bx - e_rem) * NWAVES + pw_; it < NITEMS + I_DOWN; it += e_idle * NWAVES) { if (it < I_DOWN) PREP_ITEM(0, NITEMS - I_DOWN + it); else PREP_ITEM(1, it - I_DOWN); }
            }
        }
        GRID_BAR();

        if (PH(7))
        {
            pg8::Gemm g{ACT, WDOWN, MMAIN, D, DFF}; pg8::StaticOrder S; S.init(MMAIN, D, G, bx); S.strip_base = MMAIN;
            { OPAQUE_TID(); pg8::Unit u; for (int i = 0; S.next(i, u); ++i) for (int pmf = u.pm; pmf >= 0; pmf = (pmf != 64 && S.strip_rows(u) == MMAIN) ? 64 : -1) if (pmf >= 1) act_fixup(ptid, pmf, ACT, INP(I_CONVW) + (size_t)l * 3 * DFF, INP(I_CONVB) + (size_t)l * DFF, Gtop, Vtop, Gbot); }
            VM_WAIT(); __syncthreads();
            EpiRes E{XB, RS, RSX};
            pg8::gemm_phase<EpiRes, pg8::StaticOrder, true>(lds, lds + XS_OFF, g, S, E);
        }
        GRID_BAR();
    }

#ifdef TMO_CHECK
    {
        const unsigned tmo = __hip_atomic_load((unsigned*)(ws + WS_CTL) + CW_BAR + XB_TMO, __ATOMIC_RELAXED, __HIP_MEMORY_SCOPE_AGENT);
        const unsigned nz = __hip_atomic_load((unsigned*)(ws + WS_CTL) + 8, __ATOMIC_RELAXED, __HIP_MEMORY_SCOPE_AGENT);
        if (tmo != 0u || nz != 0u) { const float val = (nz != 0u) ? 1.0e6f : 1.0e3f; for (int i = bx * 512 + threadIdx.x; i < NS * D; i += G * 512) out[O_YS + i] = val; return; }
    }
#endif
    if (PH(8))
    {
    OPAQUE_TID(); const int pgw = bx * NWAVES + __builtin_amdgcn_readfirstlane(ptid >> 6);
    for (int m = pgw; m < M; m += NGW) {
        float* dst;
        if (m < MP) { const int b = m / LSEQ, t = m - b * LSEQ; if (t < NMETA) continue; dst = out + O_YP + ((size_t)(b * SEQ + t - NMETA)) * D; }
        else dst = out + O_YS + (size_t)(m - MP) * D;
        const v2u* s2 = (const v2u*)(XB + (size_t)m * D) + plane; f32x4 v[4]; float ss = 0.f;
#pragma unroll
        for (int j = 0; j < 4; ++j) { const v2u w = s2[64 * j]; v[j] = (f32x4){bflo(w.x), bfhi(w.x), bflo(w.y), bfhi(w.y)}; ss += (v[j].x * v[j].x + v[j].y * v[j].y) + (v[j].z * v[j].z + v[j].w * v[j].w); }
        float rstd = 1.0f / sqrtf(wave_sum(ss) * (1.0f / D) + RMS_EPS);
#if defined(GEMM_DBG) && !defined(DBG_ABS_ONLY)
        if (m >= MP) { const float us = (float)MISC[50] * 0.01f; rstd *= 1.0f + sqrtf(us * 1e-3f); }
#endif
#ifdef TS_I
        if (m >= MP) { const unsigned long long ta = ((unsigned long long)MISC[17 + 2 * (TS_I)] << 32) | MISC[16 + 2 * (TS_I)], tb = ((unsigned long long)MISC[17 + 2 * (TS_J)] << 32) | MISC[16 + 2 * (TS_J)];
            const float us = (float)(tb - ta) * 0.01f; rstd *= 1.0f + sqrtf(us * 1e-3f); }
#endif
        const f32x4* g4 = (const f32x4*)INP(I_NFG) + plane; f32x4* d4 = (f32x4*)dst + plane;
#pragma unroll
        for (int j = 0; j < 4; ++j) __builtin_nontemporal_store(v[j] * rstd * g4[64 * j], d4 + 64 * j);
    }
    }
#ifdef GEMM_DBG
    if (bx == 0 && threadIdx.x == 0) out[O_POOLP] += (float)MISC[51] * 0.01f * 0.01f;
#endif
#ifdef DBG_B
    if (bx == DBG_BLK && threadIdx.x == 0) out[O_POOLP] += (float)MISC[DBG_B] * 0.01f * 0.01f;
#endif
#ifdef DBG_P
    if (bx == 7 && threadIdx.x == 0) out[O_POOLP] += (float)MISC[54 + DBG_P] * 0.01f * 0.01f;
#endif
#ifdef DBG_S
    if (bx == 8 && threadIdx.x == 0) out[O_POOLP] += (float)MISC[54] * 0.01f * 0.1f;
#endif
#ifdef TS2_I
    if (bx == 0 && threadIdx.x == 0) { const unsigned long long ta = ((unsigned long long)MISC[17 + 2 * (TS2_I)] << 32) | MISC[16 + 2 * (TS2_I)], tb = ((unsigned long long)MISC[17 + 2 * (TS2_J)] << 32) | MISC[16 + 2 * (TS2_J)];
        out[O_POOLP] += (float)(tb - ta) * 0.01f * 0.01f; }
#endif
}

extern "C" void kernel_launch(void* const* d_in, const int* in_sizes, int n_in, void* d_out, int out_size, void* d_ws, size_t ws_size, hipStream_t stream) {
    static int grid = 0;
    if (grid == 0) {
        if (n_in != N_IN || (size_t)out_size != O_END || ws_size < WS_END) { fprintf(stderr, "kernel_launch: unexpected shapes: n_in %d out %d ws %zu\n", n_in, out_size, ws_size); grid = -1; return; }
        int dev = 0, cus = 0, per_cu = 0;
        if (hipGetDevice(&dev) != hipSuccess || hipDeviceGetAttribute(&cus, hipDeviceAttributeMultiprocessorCount, dev) != hipSuccess) { grid = -1; return; }
        if (hipFuncSetAttribute((const void*)mk_fwd, hipFuncAttributeMaxDynamicSharedMemorySize, LDS_BYTES) != hipSuccess) { fprintf(stderr, "kernel_launch: hipFuncSetAttribute failed\n"); grid = -1; return; }
        if (hipOccupancyMaxActiveBlocksPerMultiprocessor(&per_cu, (const void*)mk_fwd, NWAVES * 64, LDS_BYTES) != hipSuccess || per_cu < 1) { fprintf(stderr, "kernel_launch: occupancy query says %d blocks per CU\n", per_cu); }
        (void)hipGetLastError();
        grid = cus;
    }
    if (grid < 0) return;
    if (hipMemsetAsync((char*)d_ws + WS_CTL, 0, CTL_ZERO_BYTES, stream) != hipSuccess) { fprintf(stderr, "kernel_launch: memset failed\n"); return; }
    Args a{};
    for (int i = 0; i < N_IN; ++i) a.in[i] = (const float*)d_in[i];
    a.out = (float*)d_out; a.ws = (unsigned char*)d_ws; a.pad = 0ull;
    hipLaunchKernelGGL(mk_fwd, dim3(grid), dim3(NWAVES * 64), LDS_BYTES, stream, a);
    const hipError_t le = hipPeekAtLastError();
    if (le != hipSuccess) fprintf(stderr, "kernel_launch: launch failed: %s\n", hipGetErrorName(le));
}
```

```cpp
#include <hip/hip_runtime.h>
#include <cstdio>
#include <cstdint>
namespace pg8 {
#define PG8_LAS __attribute__((address_space(3)))
typedef unsigned short bf16_t;
typedef short bf16x8 __attribute__((ext_vector_type(8)));
typedef float f32x4 __attribute__((ext_vector_type(4)));
typedef unsigned u32x4 __attribute__((ext_vector_type(4)));
constexpr int BM = 256, BK = 64, HALF = 128, HTB = HALF * BK * 2  , STAGE_BYTES = 8 * HTB, NXCD = 8, WGM = 8;

__host__ __device__ __forceinline__ int lds_byte(int r, int c) { const int st = (r >> 4) * 2 + (c >> 5), rr = r & 15, cc = c & 31, ob = rr * 64 + cc * 2; return st * 1024 + (ob ^ (((ob >> 9) & 1) << 5)); }
__host__ __device__ __forceinline__ void stage_rc(int b, int& R, int& C) { const int st = b / 1024, sb = b % 1024, swz = sb ^ (((sb >> 9) & 1) << 5); R = (st >> 1) * 16 + swz / 64; C = (st & 1) * 32 + (swz % 64) / 2; }
__host__ __device__ __forceinline__ int perm32(int rho) { const int n = rho >> 4, i = rho & 15; return 8 * (i >> 2) + 4 * n + (i & 3); }

struct Unit { int pm, pn; };
struct Gemm { const bf16_t* A; const bf16_t* Bt; int M, N, K; };

struct StaticOrder {
    int nM, nN, nwg, G, c;
    __host__ __device__ __forceinline__ void init(int M, int N, int G_, int c_) { nM = M / BM; nN = N / BM; nwg = nM * nN; G = G_; c = c_; }
    __host__ __device__ __forceinline__ bool next(int i, Unit& u) const {
        int L = i * G + c; if (L >= nwg) return false;
        if (swapE) {
            if (L >= 1287 && (L & 7) == 7) { const int k = (L - 1287) >> 3; if (k < 18) L = 1174 + k; }
            else if (L >= 1174 && L < 1192) L = 1287 + 8 * (L - 1174);
        }
        int wgid = L; { const int q = nwg / NXCD, r = nwg % NXCD, xcd = wgid % NXCD, off = wgid / NXCD; wgid = (xcd < r ? xcd * (q + 1) : r * (q + 1) + (xcd - r) * q) + off; }
        const int nig = WGM * nN, gid = wgid / nig, fm = gid * WGM, gsz = (nM - fm) < WGM ? (nM - fm) : WGM;
        u.pm = fm + ((wgid % nig) % gsz); u.pn = (wgid % nig) / gsz; return true;
    }
    int swapE = 0;
    int strip_base = -1;
    __host__ __device__ __forceinline__ int strip_rows(const Unit& u) const { return (strip_base >= 0 && (u.pm & 3) == ((u.pn + (u.pn >> 2)) & 3)) ? strip_base + 16 * (u.pm >> 2) : -1; }
    __device__ __forceinline__ void a_ready(const Unit&) const {}
    __device__ __forceinline__ void done(const Unit&) const {}
};

__device__ __forceinline__ unsigned cvt_pk_bf16(float lo, float hi) { unsigned r; asm volatile("v_cvt_pk_bf16_f32 %0, %1, %2" : "=v"(r) : "v"(lo), "v"(hi)); return r; }
constexpr int XS_BYTES = 2048;
template <class Epi, class Sched, bool STRIP>
__device__ __forceinline__ void gemm_phase(PG8_LAS unsigned char* lds, PG8_LAS unsigned char* xs  , const Gemm g, const Sched& S, const Epi& E) {
    int tid_op = threadIdx.x; asm volatile("" : "+v"(tid_op));
    const int tid = tid_op, wid = __builtin_amdgcn_readfirstlane(tid >> 6), lane = tid & 63, wr = wid >> 2, wc = wid & 3, fr = lane & 15, fq = lane >> 4;
    const int K = g.K, nt = K / BK;
    unsigned voffA[2], voffB[2];
#pragma unroll
    for (int i = 0; i < 2; ++i) { int R, C; stage_rc(tid * 16 + i * 8192, R, C); const int Rb = Epi::PERM ? ((R & ~31) + perm32(R & 31)) : R;
        voffA[i] = (unsigned)(R * K + C) * 2u; voffB[i] = (unsigned)(Rb * K + C) * 2u; }
    const bool xw = wid < 2;
    const int xR = 8 * (wid & 1) + (lane >> 3); const unsigned voffX = (unsigned)(xR * K + 8 * ((lane & 7) ^ (xR & 7))) * 2u;
    const int xoff0 = fr * 128 + ((fq ^ (fr & 7)) * 16), xoff1 = fr * 128 + (((4 + fq) ^ (fr & 7)) * 16);
    const size_t kstep = (size_t)(BK * 2), hstep = (size_t)HALF * K * 2, tstep = 2 * hstep;
    const unsigned ldsw = (unsigned)wid * 1024u;
    const int aoff = lds_byte(wr * 64 + fr, fq * 8), boff = lds_byte(wc * 32 + fr, fq * 8);
#define PG8_SA(b, h) (((b) * 2 + (h)) * HTB)
#define PG8_SB(b, h) ((4 + (b) * 2 + (h)) * HTB)
#define PG8_STAGE(bufoff, gbase, voff) do { _Pragma("unroll") for (int _i = 0; _i < 2; ++_i) \
        __builtin_amdgcn_global_load_lds((const unsigned*)((const char*)(gbase) + (voff)[_i]), (PG8_LAS unsigned*)(lds + (bufoff) + ldsw + _i * 8192), 16, 0, 0); } while (0)
#define PG8_STAGEX(b, gbase) do { if constexpr (STRIP) { if (xw) \
        __builtin_amdgcn_global_load_lds((const unsigned*)((const char*)(gbase) + voffX), (PG8_LAS unsigned*)(xs + (b) * XS_BYTES + wid * 1024), 16, 0, 0); } } while (0)
#define PG8_LDA(dst, b, h) do { _Pragma("unroll") for (int m = 0; m < 4; ++m) _Pragma("unroll") for (int k = 0; k < 2; ++k) dst[m][k] = *(const PG8_LAS bf16x8*)(lds + PG8_SA(b, h) + aoff + m * 2048 + k * 1024); } while (0)
#define PG8_LDB(dst, b, h) do { _Pragma("unroll") for (int n = 0; n < 2; ++n) _Pragma("unroll") for (int k = 0; k < 2; ++k) dst[n][k] = *(const PG8_LAS bf16x8*)(lds + PG8_SB(b, h) + boff + n * 2048 + k * 1024); } while (0)
#define PG8_LDX(b) do { if constexpr (STRIP) if (cstrip >= 0) { Ax[0] = *(const PG8_LAS bf16x8*)(xs + (b) * XS_BYTES + xoff0); Ax[1] = *(const PG8_LAS bf16x8*)(xs + (b) * XS_BYTES + xoff1); } } while (0)
#define PG8_MMA(ai, bj, At, Bt) do { __builtin_amdgcn_s_setprio(1); _Pragma("unroll") for (int m = 0; m < 4; ++m) _Pragma("unroll") for (int n = 0; n < 2; ++n) _Pragma("unroll") for (int k = 0; k < 2; ++k) \
        acc[ai][bj][m][n] = __builtin_amdgcn_mfma_f32_16x16x32_bf16(Bt[n][k], At[m][k], acc[ai][bj][m][n], 0, 0, 0); __builtin_amdgcn_s_setprio(0); } while (0)
#define PG8_MMAX() do { if constexpr (STRIP) { if (cstrip >= 0) { \
        if (wr == 0) { _Pragma("unroll") for (int k = 0; k < 2; ++k) { accX[0] = __builtin_amdgcn_mfma_f32_16x16x32_bf16(B0[0][k], Ax[k], accX[0], 0, 0, 0); accX[1] = __builtin_amdgcn_mfma_f32_16x16x32_bf16(B1[0][k], Ax[k], accX[1], 0, 0, 0); } } \
        else         { _Pragma("unroll") for (int k = 0; k < 2; ++k) { accX[0] = __builtin_amdgcn_mfma_f32_16x16x32_bf16(B0[1][k], Ax[k], accX[0], 0, 0, 0); accX[1] = __builtin_amdgcn_mfma_f32_16x16x32_bf16(B1[1][k], Ax[k], accX[1], 0, 0, 0); } } } } } while (0)
#define PG8_WAIT_V(n) asm volatile("s_waitcnt vmcnt(" #n ")" ::: "memory")
#define PG8_WAIT_VL() do { if constexpr (STRIP) { if (xw) PG8_WAIT_V(9); else PG8_WAIT_V(8); } else PG8_WAIT_V(8); } while (0)
#define PG8_WAIT_L(n) asm volatile("s_waitcnt lgkmcnt(" #n ")" ::: "memory")
#define PG8_BAR __builtin_amdgcn_s_barrier()
#define PG8_SCHED __builtin_amdgcn_sched_barrier(0)
    Unit cur, nxt; int ui = 0;
    if (!S.next(0, cur)) return;
    f32x4 acc[2][2][4][2];
#pragma unroll
    for (int a = 0; a < 2; ++a)
#pragma unroll
        for (int b = 0; b < 2; ++b)
#pragma unroll
            for (int m = 0; m < 4; ++m)
#pragma unroll
                for (int n = 0; n < 2; ++n) acc[a][b][m][n] = (f32x4){0.f, 0.f, 0.f, 0.f};
    f32x4 accX[2] = {{0.f, 0.f, 0.f, 0.f}, {0.f, 0.f, 0.f, 0.f}};
    bf16x8 At[4][2], B0[2][2], B1[2][2], Ax[2];
    Ax[0] = (bf16x8){0, 0, 0, 0, 0, 0, 0, 0}; Ax[1] = Ax[0];
    const char* cA = (const char*)g.A + (size_t)cur.pm * tstep; const char* cB = (const char*)g.Bt + (size_t)cur.pn * tstep;
    int cstrip = STRIP ? S.strip_rows(cur) : -1;
    const char* cX = (cstrip >= 0) ? (const char*)g.A + (size_t)cstrip * K * 2 : cA;
    S.a_ready(cur);
    PG8_STAGE(PG8_SB(0, 0), cB, voffB); PG8_STAGE(PG8_SB(0, 1), cB + hstep, voffB); PG8_STAGE(PG8_SA(0, 0), cA, voffA); PG8_STAGEX(0, cX); PG8_STAGE(PG8_SA(0, 1), cA + hstep, voffA);
    if (wr == 1) PG8_BAR;
    PG8_WAIT_V(2); PG8_BAR;
    PG8_STAGE(PG8_SB(1, 0), cB + kstep, voffB); PG8_STAGE(PG8_SA(1, 0), cA + kstep, voffA); PG8_STAGE(PG8_SB(1, 1), cB + hstep + kstep, voffB); PG8_STAGEX(1, cX + kstep);
    if constexpr (STRIP) { if (xw) PG8_WAIT_V(7); else PG8_WAIT_V(6); } else PG8_WAIT_V(6);
    PG8_BAR;
    for (;;) {
        const bool has_next = S.next(ui + 1, nxt);
        const char* nA = has_next ? (const char*)g.A + (size_t)nxt.pm * tstep : cA; const char* nB = has_next ? (const char*)g.Bt + (size_t)nxt.pn * tstep : cB;
        const int nstrip = (STRIP && has_next) ? S.strip_rows(nxt) : -1;
        const char* nX = has_next ? ((nstrip >= 0) ? (const char*)g.A + (size_t)nstrip * K * 2 : nA) : cX;
        for (int t = 0; t < nt; t += 2) {
            const bool last = (t == nt - 2);
            const char* a1 = cA + (size_t)(t + 1) * kstep;
            const char* a2 = last ? nA : cA + (size_t)(t + 2) * kstep; const char* b2 = last ? nB : cB + (size_t)(t + 2) * kstep; const char* x2 = last ? nX : cX + (size_t)(t + 2) * kstep;
            const char* a3 = a2 + kstep; const char* b3 = b2 + kstep; const char* x3 = x2 + kstep;
            if (last && has_next) S.a_ready(nxt);
            PG8_LDB(B0, 0, 0); PG8_LDB(B1, 0, 1); PG8_SCHED; PG8_LDA(At, 0, 0); PG8_LDX(0); PG8_STAGE(PG8_SA(1, 1), a1 + hstep, voffA);
            PG8_WAIT_VL(); PG8_WAIT_L(0); PG8_BAR; PG8_MMA(0, 0, At, B0); PG8_MMA(0, 1, At, B1); PG8_MMAX(); PG8_BAR; PG8_SCHED;
            PG8_LDA(At, 0, 1); PG8_STAGE(PG8_SB(0, 0), b2, voffB); PG8_STAGE(PG8_SB(0, 1), b2 + hstep, voffB); PG8_STAGE(PG8_SA(0, 0), a2, voffA); PG8_STAGEX(0, x2);
            PG8_WAIT_VL(); PG8_WAIT_L(0); PG8_BAR; PG8_MMA(1, 0, At, B0); PG8_MMA(1, 1, At, B1); PG8_BAR; PG8_SCHED;
            PG8_LDB(B0, 1, 0); PG8_LDB(B1, 1, 1); PG8_SCHED; PG8_LDA(At, 1, 0); PG8_LDX(1); PG8_STAGE(PG8_SA(0, 1), a2 + hstep, voffA);
            PG8_WAIT_VL(); PG8_WAIT_L(0); PG8_BAR; PG8_MMA(0, 0, At, B0); PG8_MMA(0, 1, At, B1); PG8_MMAX(); PG8_BAR; PG8_SCHED;
            PG8_LDA(At, 1, 1); PG8_STAGE(PG8_SB(1, 0), b3, voffB); PG8_STAGE(PG8_SB(1, 1), b3 + hstep, voffB); PG8_STAGE(PG8_SA(1, 0), a3, voffA); PG8_STAGEX(1, x3);
            PG8_WAIT_VL(); PG8_WAIT_L(0); PG8_BAR; PG8_MMA(1, 0, At, B0); PG8_MMA(1, 1, At, B1); PG8_BAR; PG8_SCHED;
        }
        typename Epi::MainPre mp_{}; typename Epi::StripPre sp_{};
        if constexpr (Epi::MAIN_PRE) mp_ = E.main_pre(cur, wr, wc, fr, fq);
        if constexpr (STRIP && Epi::STRIP_PRE) { if (cstrip >= 0) sp_ = E.strip_pre(cur, cstrip, wr, wc, fr, fq); }
        if (wr == 0) PG8_BAR;
        if constexpr (Epi::MAIN_PRE) E(acc, cur, ui, wr, wc, fr, fq, mp_); else E(acc, cur, ui, wr, wc, fr, fq);
        if constexpr (STRIP) { if (cstrip >= 0) { if constexpr (Epi::STRIP_PRE) E.strip(accX, cur, cstrip, ui, wr, wc, fr, fq, sp_); else E.strip(accX, cur, cstrip, ui, wr, wc, fr, fq); } }
        if constexpr (Epi::FINISH) E.finish(acc, accX, cur, cstrip, wr, wc, fr, fq);
        if constexpr (STRIP) { if (cstrip >= 0) { accX[0] = (f32x4){0.f, 0.f, 0.f, 0.f}; accX[1] = (f32x4){0.f, 0.f, 0.f, 0.f}; } }
        S.done(cur);
        if (!has_next) break;
#pragma unroll
        for (int a = 0; a < 2; ++a)
#pragma unroll
            for (int b = 0; b < 2; ++b)
#pragma unroll
                for (int m = 0; m < 4; ++m)
#pragma unroll
                    for (int n = 0; n < 2; ++n) acc[a][b][m][n] = (f32x4){0.f, 0.f, 0.f, 0.f};
        cur = nxt; cA = nA; cB = nB; cX = nX; cstrip = nstrip; ++ui;
        if (wr == 1) PG8_BAR;
    }
    PG8_WAIT_V(0);
    PG8_BAR;
#undef PG8_SA
#undef PG8_SB
#undef PG8_STAGE
#undef PG8_STAGEX
#undef PG8_LDA
#undef PG8_LDB
#undef PG8_LDX
#undef PG8_MMA
#undef PG8_MMAX
#undef PG8_WAIT_V
#undef PG8_WAIT_VL
#undef PG8_WAIT_L
#undef PG8_BAR
#undef PG8_SCHED
}
}

constexpr int D = 1024, NB = 8, SEQ = 2048, NMETA = 16, LSEQ = 2064, MP = NB * LSEQ, NS = 128, M = MP + NS;
constexpr int PW = 512, SW = 512, NIN = 3072, DFF = 2816, NUP = 5632, NG = 32, NST = 64, PHIST = 15;
constexpr int DEPTH = 2;
constexpr float RMS_EPS = 1e-6f;
static_assert(M % 256 == 0, "M");

constexpr size_t MiB = 1u << 20;
constexpr size_t WS_CTL = 0, CTL_ZERO_BYTES = 32 * 1024;
constexpr size_t WS_RS = 1 * MiB;
constexpr size_t WS_SM = 3 * MiB;
constexpr size_t WS_RSX = WS_SM + 3 * MiB / 4 + MiB / 8;
constexpr size_t WS_HS = WS_SM + MiB / 4;
constexpr size_t WS_GTOP = 4 * MiB, WS_VTOP = WS_GTOP + 3 * MiB / 2, WS_GBOT = WS_VTOP + 3 * MiB / 2;
constexpr size_t WS_W0 = 9 * MiB, WS_WSTRIDE = 27 * MiB;
constexpr size_t WO_IN = 0, WO_GLU = 6 * MiB, WO_OUT = 8 * MiB, WO_UP = 10 * MiB, WO_DOWN = 21 * MiB, WO_POOL = WO_DOWN + 11 * MiB / 2;
constexpr size_t WS_T0 = WS_W0 + 2 * WS_WSTRIDE, WS_TSTRIDE = 8 * MiB;
constexpr size_t TO_WS = 0, TO_TOEP = 2 * MiB, TO_WY = 6 * MiB;
constexpr size_t WS_XB = WS_T0 + 2 * WS_TSTRIDE;
constexpr size_t WS_YS = WS_XB + 65 * MiB / 2;
constexpr size_t WS_UP = WS_YS + 65 * MiB / 4;
constexpr size_t WS_US = WS_UP + 65 * MiB / 4;
constexpr size_t WS_GP = WS_US + 65 * MiB / 4;
constexpr size_t WS_GS = WS_GP + 65 * MiB / 2;
constexpr size_t WS_ACT = WS_UP;
constexpr size_t WS_END = WS_GS + 65 * MiB / 2;
static_assert(WS_ACT + (size_t)M * DFF * 2 <= WS_END, "act overlay");
static_assert(WS_GBOT + (size_t)65 * 2 * DFF * 4 <= WS_W0, "edge buffers");
static_assert(WO_POOL + 4 * 256 * 128 * 2 <= WS_WSTRIDE, "weights");
static_assert(WS_END <= 256 * MiB, "workspace");

constexpr int CW_BAR = 4096;

constexpr int LDS_BYTES = 163840;
constexpr int XCH_OFF = 131072;
constexpr int RSTD_OFF = XCH_OFF + 4096, RSTD_UNITS = 16, RSTD_STRIDE = 272, PRM_OFF = RSTD_OFF + RSTD_UNITS * RSTD_STRIDE * 4;
constexpr int XS_OFF = PRM_OFF + 2048;
constexpr int MMAIN = 16384;
static_assert(XS_OFF + 4096 <= LDS_BYTES - 256, "LDS map");
constexpr int LDSCTL_OFF = LDS_BYTES - 256, MISC_OFF = LDSCTL_OFF;

#define GAS __attribute__((address_space(1)))
#define LAS __attribute__((address_space(3)))
typedef unsigned short bf16;
typedef unsigned v4u __attribute__((ext_vector_type(4)));
typedef unsigned v2u __attribute__((ext_vector_type(2)));
typedef float f32x4 __attribute__((ext_vector_type(4)));
typedef float f32x2 __attribute__((ext_vector_type(2)));
typedef short bf16x8 __attribute__((ext_vector_type(8)));
typedef GAS unsigned gu32;
#define LDS_WAIT() asm volatile("s_waitcnt lgkmcnt(0)" ::: "memory")
#define VM_WAIT() asm volatile("s_waitcnt vmcnt(0)" ::: "memory")
__device__ __forceinline__ unsigned f2bf(float f) { unsigned u = __builtin_bit_cast(unsigned, f); return (u + 0x7fffu + ((u >> 16) & 1u)) >> 16; }
__device__ __forceinline__ unsigned pk2(float lo, float hi) { return f2bf(lo) | (f2bf(hi) << 16); }
__device__ __forceinline__ float bflo(unsigned w) { return __builtin_bit_cast(float, w << 16); }
__device__ __forceinline__ float bfhi(unsigned w) { return __builtin_bit_cast(float, w & 0xffff0000u); }
__device__ __forceinline__ void unpack8(v4u w, float (&f)[8]) { f[0] = bflo(w.x); f[1] = bfhi(w.x); f[2] = bflo(w.y); f[3] = bfhi(w.y); f[4] = bflo(w.z); f[5] = bfhi(w.z); f[6] = bflo(w.w); f[7] = bfhi(w.w); }
__device__ __forceinline__ v4u pack8(const float (&f)[8]) { v4u w; w.x = pg8::cvt_pk_bf16(f[0], f[1]); w.y = pg8::cvt_pk_bf16(f[2], f[3]); w.z = pg8::cvt_pk_bf16(f[4], f[5]); w.w = pg8::cvt_pk_bf16(f[6], f[7]); return w; }
__device__ __forceinline__ unsigned cvt_pk_bf16_t(float lo, float hi) { unsigned r; asm volatile("s_nop 0\n\tv_cvt_pk_bf16_f32 %0, %1, %2" : "=v"(r) : "v"(lo), "v"(hi)); return r; }
template <int CTRL> __device__ __forceinline__ float dpp_f(float v) { return __builtin_bit_cast(float, __builtin_amdgcn_update_dpp(0, __builtin_bit_cast(int, v), CTRL, 0xf, 0xf, false)); }
template <int CTRL> __device__ __forceinline__ float dppm(float v) { return __builtin_bit_cast(float, __builtin_amdgcn_mov_dpp(__builtin_bit_cast(int, v), CTRL, 0xf, 0xf, false)); }
typedef float f32x2 __attribute__((ext_vector_type(2)));
__device__ __forceinline__ f32x2 pr2(f32x4 v, int h) { f32x2 r; r.x = v[2 * h]; r.y = v[2 * h + 1]; return r; }
__device__ __forceinline__ f32x2 gelu2(f32x2 c) {
    const f32x2 K1 = {-2.302208198f, -2.302208198f}, K2 = {-0.102943240f, -0.102943240f}, one = {1.f, 1.f};
    const f32x2 q = c * __builtin_elementwise_fma(c * c, K2, K1);
    f32x2 e; e.x = __builtin_amdgcn_exp2f(q.x); e.y = __builtin_amdgcn_exp2f(q.y);
    const f32x2 d = e + one; f32x2 r; r.x = __builtin_amdgcn_rcpf(d.x); r.y = __builtin_amdgcn_rcpf(d.y);
    return c * r;
}
__device__ __forceinline__ f32x2 sigm2s(f32x2 x, float ns) {
    const f32x2 one = {1.f, 1.f}; const f32x2 q = x * ns; f32x2 e; e.x = __builtin_amdgcn_exp2f(q.x); e.y = __builtin_amdgcn_exp2f(q.y);
    const f32x2 d = e + one; f32x2 r; r.x = __builtin_amdgcn_rcpf(d.x); r.y = __builtin_amdgcn_rcpf(d.y); return r;
}
__device__ __forceinline__ float wave_sum(float v) {
#pragma unroll
    for (int o = 1; o < 64; o <<= 1) v += __shfl_xor(v, o);
    return v;
}
__device__ __forceinline__ float sigm(float x) { return __builtin_amdgcn_rcpf(1.0f + __builtin_amdgcn_exp2f(-1.4426950409f * x)); }
__device__ __forceinline__ float gelu_t(float x) { const float t = x * (1.5957691216f + 0.0713548163f * x * x); return x * __builtin_amdgcn_rcpf(1.0f + __builtin_amdgcn_exp2f(-1.4426950409f * t)); }
__device__ __forceinline__ float rstd_of(const float* RS, int r) {
    const f32x4* p = (const f32x4*)(RS + (size_t)r * 16); const f32x4 a = p[0], b = p[1], c = p[2], d = p[3];
    const float s = (((a.x + a.y) + (a.z + a.w)) + ((b.x + b.y) + (b.z + b.w))) + (((c.x + c.y) + (c.z + c.w)) + ((d.x + d.y) + (d.z + d.w)));
    return 1.0f / sqrtf(s * (1.0f / D) + RMS_EPS);
}

__device__ __forceinline__ float rs_sum(const float* RS, const float* RSX, int r, int h) {
    if (r < MMAIN) { const f32x4* p = (const f32x4*)(RS + (size_t)r * 16 + 8 * h); const f32x4 a = p[0], b = p[1]; return ((a.x + a.y) + (a.z + a.w)) + ((b.x + b.y) + (b.z + b.w)); }
    const f32x4* p = (const f32x4*)(RSX + (size_t)(r - MMAIN) * 32 + 16 * h); const f32x4 a = p[0], b = p[1], c = p[2], d = p[3];
    return (((a.x + a.y) + (a.z + a.w)) + ((b.x + b.y) + (b.z + b.w))) + (((c.x + c.y) + (c.z + c.w)) + ((d.x + d.y) + (d.z + d.w)));
}
template <class Sched> __device__ __forceinline__ void fill_rstd(LAS float* tab, const float* RS, const float* RSX, const Sched& S, int tid) {
    pg8::Unit u; int prev_pm = -1; float val = 0.f;
    for (int i = 0; i < RSTD_UNITS && S.next(i, u); ++i) {
        { const int row = tid >> 1, h = tid & 1;
          if (u.pm != prev_pm) { float s = rs_sum(RS, RSX, u.pm * 256 + row, h); s += __shfl_xor(s, 1); val = 1.0f / sqrtf(s * (1.0f / D) + RMS_EPS); prev_pm = u.pm; }
          if (h == 0) tab[i * RSTD_STRIDE + row] = val; }
        const int sr = S.strip_rows(u);
        if (sr >= 0 && tid < 32) { const int row = tid >> 1, h = tid & 1; float s = rs_sum(RS, RSX, sr + row, h); s += __shfl_xor(s, 1);
          if (h == 0) tab[i * RSTD_STRIDE + 256 + row] = 1.0f / sqrtf(s * (1.0f / D) + RMS_EPS); }
    }
    LDS_WAIT(); __syncthreads();
}

typedef f32x4 acc_t[2][2][4][2];

struct EpiIn {
    static constexpr bool PERM = true, AFTER_DRAIN = false, FINISH = false, STRIP_PRE = false, MAIN_PRE = false;
    typedef int MainPre; typedef int StripPre;
    bf16 *UP, *US, *GP, *GS; const LAS float* rstd; float* pool_p; float* pool_s;
    __device__ __forceinline__ void operator()(acc_t& acc, const pg8::Unit& u, int ui, int wr, int wc, int fr_, int fq_) const {
        int fr = fr_, fq = fq_; asm volatile("" : "+v"(fr), "+v"(fq));
        const int colt = u.pn * 256 + wc * 32 + 8 * fq;
        float rsv[2][4];
#pragma unroll
        for (int ai = 0; ai < 2; ++ai)
#pragma unroll
            for (int m = 0; m < 4; ++m) rsv[ai][m] = rstd[ui * RSTD_STRIDE + ai * 128 + wr * 64 + m * 16 + fr];
        __builtin_amdgcn_sched_barrier(0);
#pragma unroll
        for (int ai = 0; ai < 2; ++ai)
#pragma unroll
            for (int m = 0; m < 4; ++m) {
                const int r = u.pm * 256 + ai * 128 + wr * 64 + m * 16 + fr;
                const float rs = rsv[ai][m];
#pragma unroll
                for (int bj = 0; bj < 2; ++bj) {
                    const int c0 = colt + 128 * bj;
                    f32x4 v0 = acc[ai][bj][m][0], v1 = acc[ai][bj][m][1];
                    if (u.pn < 4) { v0 *= rs; v1 *= rs; }
                    if (u.pn < 2) {
                        v4u w; w.x = pg8::cvt_pk_bf16(v0[0], v0[1]); w.y = pg8::cvt_pk_bf16(v0[2], v0[3]); w.z = pg8::cvt_pk_bf16(v1[0], v1[1]); w.w = pg8::cvt_pk_bf16(v1[2], v1[3]);
                        *(v4u*)(UP + (size_t)r * PW + c0) = w;
                        if (r < MP) { const int b = r / LSEQ, t = r - b * LSEQ;
                            if (t >= LSEQ - PHIST) { float* p = pool_p + ((size_t)(b * PHIST + (t - (LSEQ - PHIST)))) * PW + c0; *(f32x4*)p = v0; *(f32x4*)(p + 4) = v1; } }
                        else { float* p = pool_s + ((size_t)((r - MP) * PHIST + (PHIST - 1))) * PW + c0; *(f32x4*)p = v0; *(f32x4*)(p + 4) = v1; }
                    } else if (u.pn < 4) {
                        v4u w; w.x = pg8::cvt_pk_bf16(v0[0], v0[1]); w.y = pg8::cvt_pk_bf16(v0[2], v0[3]); w.z = pg8::cvt_pk_bf16(v1[0], v1[1]); w.w = pg8::cvt_pk_bf16(v1[2], v1[3]);
                        *(v4u*)(US + (size_t)r * SW + (c0 - 512)) = w;
                    } else {
#pragma unroll
                        for (int j = 0; j < 1; ++j) {}
                        const float ns = -1.4426950409f * rs;
                        const f32x2 s0 = sigm2s(pr2(v0, 0), ns), s1 = sigm2s(pr2(v0, 1), ns), s2 = sigm2s(pr2(v1, 0), ns), s3 = sigm2s(pr2(v1, 1), ns);
                        v4u w; w.x = cvt_pk_bf16_t(s0.x, s0.y); w.y = cvt_pk_bf16_t(s1.x, s1.y); w.z = cvt_pk_bf16_t(s2.x, s2.y); w.w = cvt_pk_bf16_t(s3.x, s3.y);
                        if (u.pn < 8) *(v4u*)(GP + (size_t)r * D + (c0 - 1024)) = w; else *(v4u*)(GS + (size_t)r * D + (c0 - 2048)) = w;
                    }
                }
                asm volatile("" ::: "memory");
            }
    }
    __device__ __forceinline__ void strip(const f32x4 (&ax)[2], const pg8::Unit& u, int sr, int ui, int wr, int wc, int fr_, int fq_) const {
        int fr = fr_, fq = fq_; asm volatile("" : "+v"(fr), "+v"(fq));
        const int r = sr + fr; const float rs = rstd[ui * RSTD_STRIDE + 256 + fr];
#pragma unroll
        for (int bj = 0; bj < 2; ++bj) {
            const int c0 = u.pn * 256 + 128 * bj + wc * 32 + 8 * fq + 4 * wr;
            f32x4 v0 = ax[bj] * rs;
            if (u.pn < 2) {
                v2u w; w.x = pg8::cvt_pk_bf16(v0[0], v0[1]); w.y = pg8::cvt_pk_bf16(v0[2], v0[3]);
                *(v2u*)(UP + (size_t)r * PW + c0) = w;
                if (r < MP) { const int b = r / LSEQ, t = r - b * LSEQ; if (t >= LSEQ - PHIST) *(f32x4*)(pool_p + ((size_t)(b * PHIST + (t - (LSEQ - PHIST)))) * PW + c0) = v0; }
                else *(f32x4*)(pool_s + ((size_t)((r - MP) * PHIST + (PHIST - 1))) * PW + c0) = v0;
            } else if (u.pn < 4) {
                v2u w; w.x = pg8::cvt_pk_bf16(v0[0], v0[1]); w.y = pg8::cvt_pk_bf16(v0[2], v0[3]);
                *(v2u*)(US + (size_t)r * SW + (c0 - 512)) = w;
            } else {
#pragma unroll
                for (int j = 0; j < 4; ++j) v0[j] = sigm(v0[j]);
                v2u w; w.x = cvt_pk_bf16_t(v0[0], v0[1]); w.y = cvt_pk_bf16_t(v0[2], v0[3]);
                if (u.pn < 8) *(v2u*)(GP + (size_t)r * D + (c0 - 1024)) = w; else *(v2u*)(GS + (size_t)r * D + (c0 - 2048)) = w;
            }
        }
    }
};

struct EpiGlu {
    static constexpr bool PERM = true, AFTER_DRAIN = false, FINISH = false, STRIP_PRE = false, MAIN_PRE = true;
    typedef int StripPre; struct MainPre { v4u pw[4], gw[4]; };
    __device__ __forceinline__ MainPre main_pre(const pg8::Unit& u, int wr, int wc, int fr, int fq) const { MainPre p; const int c0 = u.pn * 128 + wc * 32 + 8 * fq;
#pragma unroll
        for (int m = 0; m < 4; ++m) { const size_t o = (size_t)(u.pm * 256 + wr * 64 + m * 16 + fr) * D + c0; p.pw[m] = *(const v4u*)(GP + o); p.gw[m] = *(const v4u*)(GS + o); }
        return p; }
    bf16* GP; const bf16* GS;
    __device__ __forceinline__ void operator()(acc_t& acc, const pg8::Unit& u, int ui, int wr, int wc, int fr_, int fq_, const MainPre& pre) const {
        int fr = fr_, fq = fq_; asm volatile("" : "+v"(fr), "+v"(fq));
        const int c0 = u.pn * 128 + wc * 32 + 8 * fq;
        v4u pw1[4], gw1[4];
#pragma unroll
        for (int ai = 0; ai < 2; ++ai) {
#pragma unroll
            for (int m = 0; m < 4; ++m) {
                if (ai == 0 && m == 2) {
                    __builtin_amdgcn_sched_barrier(0);
#pragma unroll
                    for (int m2 = 0; m2 < 4; ++m2) { const size_t o2 = (size_t)(u.pm * 256 + 128 + wr * 64 + m2 * 16 + fr) * D + c0; pw1[m2] = *(const v4u*)(GP + o2); gw1[m2] = *(const v4u*)(GS + o2); }
                    __builtin_amdgcn_sched_barrier(0);
                }
                const size_t o = (size_t)(u.pm * 256 + ai * 128 + wr * 64 + m * 16 + fr) * D + c0;
                float pv[8], gv[8], ov[8]; unpack8((ai == 0) ? pre.pw[m] : pw1[m], pv); unpack8((ai == 0) ? pre.gw[m] : gw1[m], gv);
#pragma unroll
                for (int n = 0; n < 2; ++n)
#pragma unroll
                    for (int h = 0; h < 2; ++h) {
                        const f32x2 sg = sigm2s(pr2(acc[ai][1][m][n], h), -1.4426950409f); f32x2 p2, g2; p2.x = pv[4 * n + 2 * h]; p2.y = pv[4 * n + 2 * h + 1]; g2.x = gv[4 * n + 2 * h]; g2.y = gv[4 * n + 2 * h + 1];
                        const f32x2 r = __builtin_elementwise_fma(g2 * pr2(acc[ai][0][m][n], h), sg, p2); ov[4 * n + 2 * h] = r.x; ov[4 * n + 2 * h + 1] = r.y; }
                *(v4u*)(GP + o) = pack8(ov);
            }
            asm volatile("" ::: "memory");
        }
    }
    __device__ __forceinline__ void strip(const f32x4 (&ax)[2], const pg8::Unit& u, int sr, int ui, int wr, int wc, int fr_, int fq_) const {
        int fr = fr_, fq = fq_; asm volatile("" : "+v"(fr), "+v"(fq));
        const size_t o = (size_t)(sr + fr) * D + u.pn * 128 + wc * 32 + 8 * fq + 4 * wr;
        const v2u pw = *(const v2u*)(GP + o), gw = *(const v2u*)(GS + o);
        const float pv[4] = {bflo(pw.x), bfhi(pw.x), bflo(pw.y), bfhi(pw.y)}, gv[4] = {bflo(gw.x), bfhi(gw.x), bflo(gw.y), bfhi(gw.y)};
        float ov[4];
#pragma unroll
        for (int j = 0; j < 4; ++j) ov[j] = pv[j] + gv[j] * ax[0][j] * sigm(ax[1][j]);
        v2u w; w.x = pg8::cvt_pk_bf16(ov[0], ov[1]); w.y = pg8::cvt_pk_bf16(ov[2], ov[3]);
        *(v2u*)(GP + o) = w;
    }
};

struct EpiRes {
    static constexpr bool PERM = true, AFTER_DRAIN = false, FINISH = false, STRIP_PRE = true, MAIN_PRE = true;
    struct MainPre { v4u xw[4][2]; };
    __device__ __forceinline__ MainPre main_pre(const pg8::Unit& u, int wr, int wc, int fr, int fq) const { MainPre p; const int colt = u.pn * 256 + wc * 32 + 8 * fq;
#pragma unroll
        for (int m = 0; m < 4; ++m)
#pragma unroll
            for (int bj = 0; bj < 2; ++bj) p.xw[m][bj] = *(const v4u*)(XB + (size_t)(u.pm * 256 + wr * 64 + m * 16 + fr) * D + colt + 128 * bj);
        return p; }
    struct StripPre { v2u x[2]; };
    __device__ __forceinline__ StripPre strip_pre(const pg8::Unit& u, int sr, int wr, int wc, int fr, int fq) const {
        StripPre p;
#pragma unroll
        for (int bj = 0; bj < 2; ++bj) p.x[bj] = *(const v2u*)(XB + (size_t)(sr + fr) * D + u.pn * 256 + 128 * bj + wc * 32 + 8 * fq + 4 * wr);
        return p; }
    bf16* XB; float* RS; float* RSX;
    __device__ __forceinline__ void operator()(acc_t& acc, const pg8::Unit& u, int ui, int wr, int wc, int fr_, int fq_, const MainPre& pre) const {
        int fr = fr_, fq = fq_; asm volatile("" : "+v"(fr), "+v"(fq));
        const int colt = u.pn * 256 + wc * 32 + 8 * fq;
        v4u xb1[4][2];
#pragma unroll
        for (int ai = 0; ai < 2; ++ai) {
#pragma unroll
            for (int m = 0; m < 4; ++m) {
                if (ai == 0 && m == 2) {
                    __builtin_amdgcn_sched_barrier(0);
#pragma unroll
                    for (int m2 = 0; m2 < 4; ++m2)
#pragma unroll
                        for (int bj = 0; bj < 2; ++bj) xb1[m2][bj] = *(const v4u*)(XB + (size_t)(u.pm * 256 + 128 + wr * 64 + m2 * 16 + fr) * D + colt + 128 * bj);
                    __builtin_amdgcn_sched_barrier(0);
                }
                const int r = u.pm * 256 + ai * 128 + wr * 64 + m * 16 + fr;
                float ss = 0.f;
#pragma unroll
                for (int bj = 0; bj < 2; ++bj) {
                    float xv[8], xr[8]; unpack8((ai == 0) ? pre.xw[m][bj] : xb1[m][bj], xv);
#pragma unroll
                    for (int n = 0; n < 2; ++n)
#pragma unroll
                        for (int j = 0; j < 4; ++j) xv[4 * n + j] += acc[ai][bj][m][n][j];
                    const v4u w = pack8(xv); *(v4u*)(XB + (size_t)r * D + colt + 128 * bj) = w; unpack8(w, xr);
                    ss += ((xr[0] * xr[0] + xr[1] * xr[1]) + (xr[2] * xr[2] + xr[3] * xr[3])) + ((xr[4] * xr[4] + xr[5] * xr[5]) + (xr[6] * xr[6] + xr[7] * xr[7]));
                }
                ss += __shfl_xor(ss, 16); ss += __shfl_xor(ss, 32);
                if (fq == 0) { if (r < MMAIN) RS[(size_t)r * 16 + u.pn * 4 + wc] = ss; else { RSX[(size_t)(r - MMAIN) * 32 + (u.pn * 4 + wc) * 2] = ss; RSX[(size_t)(r - MMAIN) * 32 + (u.pn * 4 + wc) * 2 + 1] = 0.f; } }
            }
            asm volatile("" ::: "memory");
        }
    }
    __device__ __forceinline__ void strip(const f32x4 (&ax)[2], const pg8::Unit& u, int sr, int ui, int wr, int wc, int fr_, int fq_, const StripPre& pre) const {
        int fr = fr_, fq = fq_; asm volatile("" : "+v"(fr), "+v"(fq));
        const int r = sr + fr; float ss = 0.f;
#pragma unroll
        for (int bj = 0; bj < 2; ++bj) {
            bf16* xp = XB + (size_t)r * D + u.pn * 256 + 128 * bj + wc * 32 + 8 * fq + 4 * wr;
            const v2u xw = pre.x[bj];
            const float x0 = bflo(xw.x) + ax[bj][0], x1 = bfhi(xw.x) + ax[bj][1], x2 = bflo(xw.y) + ax[bj][2], x3 = bfhi(xw.y) + ax[bj][3];
            v2u w; w.x = pg8::cvt_pk_bf16(x0, x1); w.y = pg8::cvt_pk_bf16(x2, x3); *(v2u*)xp = w;
            const float y0 = bflo(w.x), y1 = bfhi(w.x), y2 = bflo(w.y), y3 = bfhi(w.y); ss += (y0 * y0 + y1 * y1) + (y2 * y2 + y3 * y3);
        }
        ss += __shfl_xor(ss, 16); ss += __shfl_xor(ss, 32);
        if (fq == 0) RSX[(size_t)(r - MMAIN) * 32 + (u.pn * 4 + wc) * 2 + wr] = ss;
    }
};

constexpr int CW_FIN = 1024;
struct EpiResFin {
    static constexpr bool PERM = true, AFTER_DRAIN = false, FINISH = true, STRIP_PRE = false, MAIN_PRE = true;
    typedef int StripPre; struct MainPre { v4u xw[4][2]; };
    __device__ __forceinline__ MainPre main_pre(const pg8::Unit& u, int wr, int wc, int fr, int fq) const { MainPre p; const int colt = u.pn * 256 + wc * 32 + 8 * fq;
#pragma unroll
        for (int m = 0; m < 4; ++m)
#pragma unroll
            for (int bj = 0; bj < 2; ++bj) p.xw[m][bj] = *(const v4u*)(XB + (size_t)(u.pm * 256 + wr * 64 + m * 16 + fr) * D + colt + 128 * bj);
        return p; }
    const bf16* XB; float* RS; float* RSX; unsigned* cnt; const float* gain; float* yp; float* ys; LAS float* tab; LAS unsigned char* ylds;
    __device__ __forceinline__ void operator()(acc_t& acc, const pg8::Unit& u, int ui, int wr, int wc, int fr_, int fq_, const MainPre& pre) const {
        int fr = fr_, fq = fq_; asm volatile("" : "+v"(fr), "+v"(fq));
        const int colt = u.pn * 256 + wc * 32 + 8 * fq;
#pragma unroll
        for (int ai = 0; ai < 2; ++ai) {
            v4u xw[4][2];
#pragma unroll
            for (int m = 0; m < 4; ++m)
#pragma unroll
                for (int bj = 0; bj < 2; ++bj) { if (ai == 0) xw[m][bj] = pre.xw[m][bj]; else xw[m][bj] = *(const v4u*)(XB + (size_t)(u.pm * 256 + ai * 128 + wr * 64 + m * 16 + fr) * D + colt + 128 * bj); }
#pragma unroll
            for (int m = 0; m < 4; ++m) {
                const int r = u.pm * 256 + ai * 128 + wr * 64 + m * 16 + fr;
                float ss = 0.f;
#pragma unroll
                for (int bj = 0; bj < 2; ++bj) {
                    float xv[8]; unpack8(xw[m][bj], xv);
#pragma unroll
                    for (int n = 0; n < 2; ++n)
#pragma unroll
                        for (int j = 0; j < 4; ++j) { const float x = acc[ai][bj][m][n][j] + xv[4 * n + j]; acc[ai][bj][m][n][j] = x; ss += x * x; }
                }
                ss += __shfl_xor(ss, 16); ss += __shfl_xor(ss, 32);
                if (fq == 0) RS[(size_t)r * 16 + u.pn * 4 + wc] = ss;
            }
            asm volatile("" ::: "memory");
        }
    }
    __device__ __forceinline__ void strip(f32x4 (&ax)[2], const pg8::Unit& u, int sr, int ui, int wr, int wc, int fr_, int fq_) const {
        int fr = fr_, fq = fq_; asm volatile("" : "+v"(fr), "+v"(fq));
        const int r = sr + fr; float ss = 0.f;
#pragma unroll
        for (int bj = 0; bj < 2; ++bj) {
            const v2u xw = *(const v2u*)(XB + (size_t)r * D + u.pn * 256 + 128 * bj + wc * 32 + 8 * fq + 4 * wr);
            const float x0 = bflo(xw.x) + ax[bj][0], x1 = bfhi(xw.x) + ax[bj][1], x2 = bflo(xw.y) + ax[bj][2], x3 = bfhi(xw.y) + ax[bj][3];
            ax[bj] = (f32x4){x0, x1, x2, x3}; ss += (x0 * x0 + x1 * x1) + (x2 * x2 + x3 * x3);
        }
        ss += __shfl_xor(ss, 16); ss += __shfl_xor(ss, 32);
        if (fq == 0) RSX[(size_t)(r - MMAIN) * 32 + (u.pn * 4 + wc) * 2 + wr] = ss;
    }
    __device__ __forceinline__ float* yrow(int r) const {
        if (r < MP) { const int b = r / LSEQ, t = r - b * LSEQ; return (t < NMETA) ? nullptr : yp + ((size_t)(b * SEQ + t - NMETA)) * D; }
        return ys + (size_t)(r - MP) * D;
    }
    __device__ __forceinline__ void finish(acc_t& acc, f32x4 (&ax)[2], const pg8::Unit& u, int sr, int wr, int wc, int fr_, int fq_) const {
        int fr = fr_, fq = fq_; asm volatile("" : "+v"(fr), "+v"(fq));
        const int lane = fr + 16 * fq, t = (wr * 4 + wc) * 64 + lane;
        const int colt = u.pn * 256 + wc * 32 + 8 * fq;
        f32x4 gv[2][2];
#pragma unroll
        for (int bj = 0; bj < 2; ++bj)
#pragma unroll
            for (int n = 0; n < 2; ++n) gv[bj][n] = *(const f32x4*)(gain + colt + 128 * bj + 4 * n);
        asm volatile("s_waitcnt vmcnt(0)" ::: "memory"); __builtin_amdgcn_s_barrier();
        if (t == 0) {
            __builtin_amdgcn_fence(__ATOMIC_RELEASE, "agent");
            __hip_atomic_fetch_add(cnt + u.pm, 1u, __ATOMIC_RELAXED, __HIP_MEMORY_SCOPE_AGENT);
            if (sr >= 0) __hip_atomic_fetch_add(cnt + 64 + ((sr - MMAIN) >> 4), 1u, __ATOMIC_RELAXED, __HIP_MEMORY_SCOPE_AGENT);
            while (__hip_atomic_load(cnt + u.pm, __ATOMIC_RELAXED, __HIP_MEMORY_SCOPE_AGENT) < 4u) __builtin_amdgcn_s_sleep(2);
            if (sr >= 0) while (__hip_atomic_load(cnt + 64 + ((sr - MMAIN) >> 4), __ATOMIC_RELAXED, __HIP_MEMORY_SCOPE_AGENT) < 4u) __builtin_amdgcn_s_sleep(2);
            __builtin_amdgcn_fence(__ATOMIC_ACQUIRE, "agent");
        }
        __builtin_amdgcn_s_barrier(); asm volatile("" ::: "memory");
        if (t < 256) { const f32x4* p = (const f32x4*)(RS + (size_t)(u.pm * 256 + t) * 16); const f32x4 a = p[0], b = p[1], c = p[2], d = p[3];
            const float s = (((a.x + a.y) + (a.z + a.w)) + ((b.x + b.y) + (b.z + b.w))) + (((c.x + c.y) + (c.z + c.w)) + ((d.x + d.y) + (d.z + d.w)));
            tab[t] = 1.0f / sqrtf(s * (1.0f / D) + RMS_EPS); }
        else if (t < 272 && sr >= 0) { const f32x4* p = (const f32x4*)(RSX + (size_t)(sr - MMAIN + t - 256) * 32); float s = 0.f;
#pragma unroll
            for (int i = 0; i < 8; ++i) { const f32x4 a = p[i]; s += (a.x + a.y) + (a.z + a.w); }
            tab[t] = 1.0f / sqrtf(s * (1.0f / D) + RMS_EPS); }
        asm volatile("s_waitcnt vmcnt(0) lgkmcnt(0)" ::: "memory"); __builtin_amdgcn_s_barrier(); asm volatile("" ::: "memory");
        constexpr int YP = 1040;
        const int wv = wr * 4 + wc;
#pragma unroll
        for (int ai = 0; ai < 2; ++ai) {
#pragma unroll
            for (int m = 0; m < 4; ++m) { const int rl = wr * 64 + m * 16 + fr; const float rs = tab[ai * 128 + rl];
#pragma unroll
                for (int bj = 0; bj < 2; ++bj)
#pragma unroll
                    for (int n = 0; n < 2; ++n) *(LAS f32x4*)(ylds + rl * YP + (128 * bj + 32 * wc + 8 * fq + 4 * n) * 4) = acc[ai][bj][m][n] * rs * gv[bj][n]; }
            asm volatile("s_waitcnt lgkmcnt(0)" ::: "memory"); __builtin_amdgcn_s_barrier(); asm volatile("" ::: "memory");
#pragma unroll 4
            for (int i = 0; i < 16; ++i) { const int rl = wv * 16 + i; float* dst = yrow(u.pm * 256 + ai * 128 + rl);
                if (dst) __builtin_nontemporal_store(*(const LAS f32x4*)(ylds + rl * YP + lane * 16), (f32x4*)(dst + u.pn * 256 + lane * 4)); }
            asm volatile("s_waitcnt lgkmcnt(0)" ::: "memory"); __builtin_amdgcn_s_barrier(); asm volatile("" ::: "memory");
        }
        if (sr >= 0) { float* dst = yrow(sr + fr); const float rs = tab[256 + fr];
            if (dst) {
#pragma unroll
                for (int bj = 0; bj < 2; ++bj) { const int c = u.pn * 256 + 128 * bj + wc * 32 + 8 * fq + 4 * wr; *(f32x4*)(dst + c) = ax[bj] * rs * *(const f32x4*)(gain + c); } }
        }
    }
};

struct EpiUp {
    static constexpr bool PERM = true, AFTER_DRAIN = false, FINISH = false, STRIP_PRE = false, MAIN_PRE = true;
    typedef int StripPre;
    bf16* ACT; const LAS float* rstd; const float* cw; const float* cb; const float* sconv; float* conv_p; float* conv_s; float* Gtop; float* Vtop; float* Gbot; LAS float* xch; LAS float* prm;
    typedef float MainPre;
    __device__ __forceinline__ MainPre main_pre(const pg8::Unit& u, int wr, int wc, int fr, int fq) const { const int t = (wr * 4 + wc) * 64 + fr + 16 * fq, k = t >> 7, c = t & 127; return (k < 3) ? cw[k * DFF + 128 * u.pn + c] : cb[128 * u.pn + c]; }
    __device__ __forceinline__ void operator()(acc_t& acc, const pg8::Unit& u, int ui, int wr, int wc, int fr_, int fq_, MainPre prm_v) const {
        int fr = fr_, fq = fq_; asm volatile("" : "+v"(fr), "+v"(fq));
        const int lane = fr + 16 * fq;
        const int gc0 = 128 * u.pn + 32 * wc + 8 * fq;
        const int r0 = u.pm * 256;
        { float rsv[2][4];
#pragma unroll
          for (int ai = 0; ai < 2; ++ai)
#pragma unroll
            for (int m = 0; m < 4; ++m) rsv[ai][m] = rstd[ui * RSTD_STRIDE + ai * 128 + wr * 64 + m * 16 + fr];
          __builtin_amdgcn_sched_barrier(0);
#pragma unroll
          for (int ai = 0; ai < 2; ++ai)
#pragma unroll
            for (int m = 0; m < 4; ++m)
#pragma unroll
                for (int bj = 0; bj < 2; ++bj) { acc[ai][bj][m][0] *= rsv[ai][m]; acc[ai][bj][m][1] *= rsv[ai][m]; } }
#pragma unroll
        for (int ai = 0; ai < 2; ++ai)
            if (fr >= 14) { LAS float* p = xch + ((((ai * 2 + wr) * 4 + wc) * 2 + (fr - 14)) * 4 + fq) * 8; *(LAS f32x4*)p = acc[ai][0][3][0]; *(LAS f32x4*)(p + 4) = acc[ai][0][3][1]; }
        if (wr == 1 && fr >= 14) { float* p = Gbot + ((size_t)(u.pm * 2 + fr - 14)) * DFF + gc0; *(f32x4*)p = acc[1][0][3][0]; *(f32x4*)(p + 4) = acc[1][0][3][1]; }
        if (wr == 0 && fr < 2) { const size_t o = ((size_t)(u.pm * 2 + fr)) * DFF + gc0;
            *(f32x4*)(Gtop + o) = acc[0][0][0][0]; *(f32x4*)(Gtop + o + 4) = acc[0][0][0][1]; *(f32x4*)(Vtop + o) = acc[0][1][0][0]; *(f32x4*)(Vtop + o + 4) = acc[0][1][0][1]; }
        { const int t = (wr * 4 + wc) * 64 + lane; prm[t] = prm_v; }
        asm volatile("s_waitcnt lgkmcnt(0)" ::: "memory"); __builtin_amdgcn_s_barrier(); asm volatile("" ::: "memory");
        const bool special = (u.pm == 0) || (u.pm * 256 >= MMAIN) || ((r0 + 257) / LSEQ != (r0 - 2) / LSEQ);
#pragma unroll
        for (int ai = 0; ai < 2; ++ai) {
            f32x4 P1[2], P2[2];
            if (wr == 1 || ai == 1) {
                const int sai = (wr == 1) ? ai : 0, swr = (wr == 1) ? 0 : 1;
                const LAS float* p = xch + ((((sai * 2 + swr) * 4 + wc) * 2 + 0) * 4 + fq) * 8;
#pragma unroll
                for (int n = 0; n < 2; ++n) { const f32x4 e2 = *(const LAS f32x4*)(p + 4 * n), e1 = *(const LAS f32x4*)(p + 32 + 4 * n); P1[n] = e1; P2[n] = (fr == 0) ? e2 : e1; }
            } else { P1[0] = P1[1] = P2[0] = P2[1] = (f32x4){0.f, 0.f, 0.f, 0.f}; }
            f32x4 w0[2], w1[2], w2[2], bb[2];
#pragma unroll
            for (int n = 0; n < 2; ++n) { const int lc = 32 * wc + 8 * fq + 4 * n; w0[n] = *(const LAS f32x4*)(prm + lc); w1[n] = *(const LAS f32x4*)(prm + 128 + lc); w2[n] = *(const LAS f32x4*)(prm + 256 + lc); bb[n] = *(const LAS f32x4*)(prm + 384 + lc); }
            __builtin_amdgcn_sched_barrier(0);
#pragma unroll
            for (int m = 0; m < 4; ++m) {
                const int r = r0 + ai * 128 + wr * 64 + m * 16 + fr;
                f32x4 R1[2], R2[2], g1[2], g2[2];
#pragma unroll
                for (int n = 0; n < 2; ++n)
#pragma unroll
                    for (int j = 0; j < 4; ++j) { const float cur = acc[ai][0][m][n][j]; R1[n][j] = dppm<0x121>(cur); R2[n][j] = dppm<0x122>(cur);
                        g1[n][j] = (fr >= 1) ? R1[n][j] : P1[n][j]; g2[n][j] = (fr >= 2) ? R2[n][j] : P2[n][j]; }
                const int g0_ = r0 + ai * 128 + wr * 64 + m * 16;
                if (special && (g0_ + 15 >= MP || g0_ < 2 || (g0_ + 17) / LSEQ != (g0_ - 2) / LSEQ)) {
                if (r < MP) {
                    const int b = r / LSEQ, t = r - b * LSEQ;
                    if (t == 0) { g1[0] = g1[1] = (f32x4){0.f, 0.f, 0.f, 0.f}; }
                    if (t <= 1) { g2[0] = g2[1] = (f32x4){0.f, 0.f, 0.f, 0.f}; }
                    if (t >= LSEQ - 2) { float* p = conv_p + ((size_t)(b * 2 + (t - (LSEQ - 2)))) * DFF + gc0; *(f32x4*)p = acc[ai][0][m][0]; *(f32x4*)(p + 4) = acc[ai][0][m][1]; }
                } else {
                    const int bs = r - MP; const float* h = sconv + ((size_t)bs * 2) * DFF + gc0;
                    g2[0] = *(const f32x4*)h; g2[1] = *(const f32x4*)(h + 4); g1[0] = *(const f32x4*)(h + DFF); g1[1] = *(const f32x4*)(h + DFF + 4);
                    float* p = conv_s + ((size_t)(bs * 2 + 1)) * DFF + gc0; *(f32x4*)p = acc[ai][0][m][0]; *(f32x4*)(p + 4) = acc[ai][0][m][1];
                }
                }
                float o[8];
#pragma unroll
                for (int n = 0; n < 2; ++n)
#pragma unroll
                    for (int h = 0; h < 2; ++h) {
                        f32x2 c = __builtin_elementwise_fma(pr2(w0[n], h), pr2(g2[n], h), pr2(bb[n], h)); c = __builtin_elementwise_fma(pr2(w1[n], h), pr2(g1[n], h), c); c = __builtin_elementwise_fma(pr2(w2[n], h), pr2(acc[ai][0][m][n], h), c);
                        const f32x2 r = gelu2(c) * pr2(acc[ai][1][m][n], h); o[4 * n + 2 * h] = r.x; o[4 * n + 2 * h + 1] = r.y; }
                __builtin_nontemporal_store(pack8(o), (v4u*)(ACT + (size_t)r * DFF + gc0));
                P1[0] = R1[0]; P1[1] = R1[1]; P2[0] = R2[0]; P2[1] = R2[1];
                if (m & 1) asm volatile("" ::: "memory");
            }
        }
    }
};
#define XB_TMO      128
#define XB_XCNT(j)  (256  + 64 * (j))
#define XB_XSUB(j)  (1280 + 64 * (j))
#define XB_XGEN(j)  (2304 + 64 * (j))
#define XB_TOP      3328
#define XB_TOPGEN   3392
#define XCD_BAR_WORDS 3456
#define XB_SPIN_CAP (1u << 18)

__device__ __forceinline__ unsigned xb_ld(unsigned* p)              { return __hip_atomic_load(p, __ATOMIC_RELAXED, __HIP_MEMORY_SCOPE_AGENT); }
__device__ __forceinline__ unsigned xb_add(unsigned* p, unsigned v) { return __hip_atomic_fetch_add(p, v, __ATOMIC_RELAXED, __HIP_MEMORY_SCOPE_AGENT); }
__device__ __forceinline__ unsigned xb_xcc_id() { return (unsigned)__builtin_amdgcn_s_getreg((3 << 11) | 20) & 0xFu; }
#define XB_SPIN(cond, bar) do { unsigned _sp = 0; while (cond) { __builtin_amdgcn_s_sleep(1); \
    if ((++_sp & 255u) == 0u) { if (xb_ld(&(bar)[XB_TMO])) break; if (_sp > XB_SPIN_CAP) { atomicAdd(&(bar)[XB_TMO], 1u); break; } } } } while (0)

struct XcdBarrier {
    unsigned* bar; unsigned x;
    volatile LAS unsigned* st;
};

__device__ __forceinline__ XcdBarrier xcd_barrier_post(unsigned* bar, volatile LAS unsigned* st) {
    XcdBarrier b; b.bar = bar; b.x = xb_xcc_id(); b.st = st;
    if (threadIdx.x == 0) (void)xb_add(&bar[XB_XCNT(b.x)], 1u);
    return b;
}
__device__ __forceinline__ void xcd_barrier_complete(unsigned* bar, unsigned x, unsigned& nloc, unsigned& nx) {
    const unsigned G = gridDim.x * gridDim.y * gridDim.z;
    unsigned sum, cnt, mine, sp = 0u;
    for (;;) {
        sum = 0u; cnt = 0u; mine = 0u;
#pragma unroll
        for (unsigned j = 0; j < 16; ++j) { const unsigned c = xb_ld(&bar[XB_XCNT(j)]); sum += c; cnt += (c > 0u) ? 1u : 0u; mine = (j == x) ? c : mine; }
        if (sum == G) break;
        __builtin_amdgcn_s_sleep(1);
        if ((++sp & 255u) == 0u) { if (xb_ld(&bar[XB_TMO])) break; if (sp > XB_SPIN_CAP) { atomicAdd(&bar[XB_TMO], 1u); break; } }
    }
    nloc = mine > 0u ? mine : 1u; nx = cnt > 0u ? cnt : 1u;
}

__device__ __forceinline__ void xcd_barrier(const XcdBarrier& b) {
    asm volatile("s_waitcnt vmcnt(0)" ::: "memory");
    __syncthreads();
    int tid0_ = threadIdx.x; asm volatile("" : "+v"(tid0_));
    if (tid0_ == 0) {
        __attribute__((address_space(1))) unsigned* barg_ = (__attribute__((address_space(1))) unsigned*)b.bar; asm volatile("" : "+s"(barg_)); unsigned* bar = (unsigned*)barg_;
        unsigned bx_ = b.x; asm volatile("" : "+s"(bx_));
        __builtin_amdgcn_s_waitcnt(0);
        unsigned nloc = b.st[0], nx = b.st[1];
        if (nloc == 0u) { xcd_barrier_complete(bar, bx_, nloc, nx); b.st[0] = nloc; b.st[1] = nx; }
        const unsigned old = xb_add(&bar[XB_XSUB(bx_)], 1u);
        const unsigned gen = old / nloc;
        if (old + 1u == (gen + 1u) * nloc) {
            __builtin_amdgcn_fence(__ATOMIC_RELEASE, "agent");
            asm volatile("s_waitcnt vmcnt(0)" ::: "memory");
            const unsigned og = xb_add(&bar[XB_TOP], 1u);
            const unsigned tg = og / nx;
            if (og + 1u == (tg + 1u) * nx) xb_add(&bar[XB_TOPGEN], 1u);
            else XB_SPIN(xb_ld(&bar[XB_TOPGEN]) == tg, bar);
            __builtin_amdgcn_fence(__ATOMIC_ACQUIRE, "agent");
            xb_add(&bar[XB_XGEN(bx_)], 1u);
            asm volatile("s_waitcnt vmcnt(0)" ::: "memory");
        } else {
            XB_SPIN(xb_ld(&bar[XB_XGEN(bx_)]) == gen, bar);
            __builtin_amdgcn_fence(__ATOMIC_ACQUIRE, "agent");
            asm volatile("s_waitcnt vmcnt(0)" ::: "memory");
        }
    }
    __syncthreads();
}

constexpr int TR_BYTES = 64 * 65 * 4;
__device__ __forceinline__ void transpose_item(const float* W, int K, int N, bf16* WT, LAS float* scr, int item, int lane, const float* rs, const float* cs, int mode) {
    const int nblk = N / 64, kb = item / nblk, nb = item % nblk, k0 = 64 * kb, n0 = 64 * nb;
    const int lr = lane >> 4, lc = (lane & 15) * 4;
    f32x4 csv = {1.f, 1.f, 1.f, 1.f}; if (cs) csv = *(const f32x4*)(cs + n0 + lc);
    {
        f32x4 v[16];
#pragma unroll
        for (int i = 0; i < 16; ++i) v[i] = __builtin_nontemporal_load((const f32x4*)(W + (size_t)(k0 + 4 * i + lr) * N + n0 + lc));
        __builtin_amdgcn_sched_barrier(0);
#pragma unroll
        for (int i = 0; i < 16; ++i) { const int kk = 4 * i + lr; f32x4 w = v[i] * csv; if (rs) w = w * rs[k0 + kk];
            LAS float* d = scr + kk * 65 + lc; d[0] = w.x; d[1] = w.y; d[2] = w.z; d[3] = w.w; }
    }
    LDS_WAIT(); asm volatile("" ::: "memory");
    int drow0 = n0;
    if (mode == 1) { const int half = N / 2; const int v = n0 < half ? n0 : n0 - half; drow0 = 256 * (v / 128) + (n0 < half ? 0 : 128) + (v % 128); }
    const int c = lane & 7;
#pragma unroll
    for (int j = 0; j < 8; ++j) { const int n = (lane >> 3) + 8 * j; const LAS float* s = scr + (8 * c) * 65 + n;
        v4u o; o.x = pk2(s[0 * 65], s[1 * 65]); o.y = pk2(s[2 * 65], s[3 * 65]); o.z = pk2(s[4 * 65], s[5 * 65]); o.w = pk2(s[6 * 65], s[7 * 65]);
        *(v4u*)(WT + (size_t)(drow0 + n) * K + k0 + 8 * c) = o; }
    LDS_WAIT(); asm volatile("" ::: "memory");
}

__device__ __forceinline__ void sincos_f(float x, float& s, float& c) {
    const float kf = rintf(x * 0.6366197724f);
    const float y = ((x - kf * 1.5703125f) - kf * 4.837512969970703125e-4f) - kf * 7.54978995489188216e-8f;
    const int k = (int)kf;
    const float y2 = y * y;
    const float sp = y * (1.0f + y2 * (-1.6666667163e-1f + y2 * (8.3333337680e-3f + y2 * (-1.9841270114e-4f + y2 * (2.7557314297e-6f + y2 * -2.5050759689e-8f)))));
    const float cp = 1.0f + y2 * (-0.5f + y2 * (4.1666667908e-2f + y2 * (-1.3888889225e-3f + y2 * (2.4801587642e-5f + y2 * (-2.7557314297e-7f + y2 * 2.0876755880e-9f)))));
    const int q = k & 3;
    s = (q == 0) ? sp : (q == 1) ? cp : (q == 2) ? -sp : -cp;
    c = (q == 0) ? cp : (q == 1) ? -sp : (q == 2) ? -cp : sp;
}

__device__ __forceinline__ void ssm_tables(LAS unsigned char* lds, int tid, int l, int g, int quad,
        const float* A_re, const float* A_im, const float* log_dt, const float* B_re, const float* B_im, const float* C_re, const float* C_im, const float* Dsk,
        bf16* TWS, bf16* TTOEP, bf16* TWY, float* SMT) {
    LAS f32x2* Pk = (LAS f32x2*)lds;
    LAS f32x2* Bb = Pk + 17 * 64;
    LAS f32x2* Cc = Bb + 64 * 16;
    LAS float* Mt = (LAS float*)(Cc + 16 * 65);
    __syncthreads();
    const int lg = l * NG + g;
    if (tid < 64) {
        const int n = tid;
        const float dt = expf(log_dt[lg]);
        const float lr = A_re[lg * 64 + n], li = A_im[lg * 64 + n];
        const float mag = expf(lr * dt); float sn, cs; sincos_f(li * dt, sn, cs);
        const float ar = mag * cs, ai = mag * sn, den = lr * lr + li * li, nr = ar - 1.0f, ni = ai;
        const float qr = (nr * lr + ni * li) / den, qi = (ni * lr - nr * li) / den;
        float pr = 1.0f, pi = 0.0f;
        for (int k = 0; k <= 16; ++k) { Pk[k * 64 + n] = (f32x2){pr, pi}; const float t = pr * ar - pi * ai; pi = pr * ai + pi * ar; pr = t; }
        if (quad == 0) { float* o = SMT + ((size_t)lg * 64 + n) * 8; const f32x2 p16 = Pk[16 * 64 + n];
            *(f32x4*)o = (f32x4){ar, ai, qr, qi}; *(f32x4*)(o + 4) = (f32x4){p16.x, p16.y, 0.f, 0.f}; }
        for (int qc = 0; qc < 16; ++qc) { const float br = B_re[((size_t)lg * 64 + n) * 16 + qc], bi = B_im[((size_t)lg * 64 + n) * 16 + qc];
            Bb[n * 16 + qc] = (f32x2){qr * br - qi * bi, qr * bi + qi * br}; }
    }
    for (int i = tid; i < 1024; i += 512) Cc[(i >> 6) * 65 + (i & 63)] = (f32x2){C_re[(size_t)lg * 1024 + i], C_im[(size_t)lg * 1024 + i]};
    LDS_WAIT(); __syncthreads();
    {
        const int tl = tid >> 7, tau = 4 * quad + tl, pp = (tid >> 3) & 15, q0 = (tid & 7) * 2; float s0 = 0.f, s1 = 0.f;
        for (int n = 0; n < 64; ++n) { const f32x2 c = Cc[pp * 65 + n], pk = Pk[tau * 64 + n];
            const float cpr = c.x * pk.x - c.y * pk.y, cpi = c.x * pk.y + c.y * pk.x;
            const f32x4 b = *(const LAS f32x4*)(Bb + n * 16 + q0);
            s0 += cpr * b.x - cpi * b.y; s1 += cpr * b.z - cpi * b.w; }
        if (tau == 0) { const float dv = Dsk[l * SW + 16 * g + pp]; if (q0 == pp) s0 += dv; if (q0 + 1 == pp) s1 += dv; }
        *(LAS f32x2*)(Mt + tl * 256 + pp * 16 + q0) = (f32x2){s0, s1};
    }
    LDS_WAIT(); __syncthreads();
    for (int it = tid; it < 8192; it += 512) {
        const int row = it >> 5, oct = it & 31, j = row >> 4, p = row & 15, i_ = oct >> 1, q0 = (oct & 1) * 8, tau = j - i_;
        if (((tau >= 0) ? (tau >> 2) : ((-tau) >> 2)) != quad) continue;
        float v[8];
#pragma unroll
        for (int e = 0; e < 8; ++e) v[e] = (tau >= 0) ? Mt[(tau - 4 * quad) * 256 + p * 16 + q0 + e] : 0.f;
        v4u o; o.x = pk2(v[0], v[1]); o.y = pk2(v[2], v[3]); o.z = pk2(v[4], v[5]); o.w = pk2(v[6], v[7]);
        *(v4u*)(TTOEP + ((size_t)(g * 256 + row)) * 256 + 8 * oct) = o;
    }
    for (int part = 2 * quad; part < 2 * quad + 2; ++part) {
    {
        const int s = 16 * part + (tid >> 5), oct = tid & 31, n = s & 63, i_ = oct >> 1, q0 = (oct & 1) * 8;
        float v[8];
#pragma unroll
        for (int e = 0; e < 8; ++e) { const f32x2 pk = Pk[(15 - i_) * 64 + n], b = Bb[n * 16 + q0 + e]; v[e] = (s < 64) ? (pk.x * b.x - pk.y * b.y) : (pk.x * b.y + pk.y * b.x); }
        v4u o; o.x = pk2(v[0], v[1]); o.y = pk2(v[2], v[3]); o.z = pk2(v[4], v[5]); o.w = pk2(v[6], v[7]);
        *(v4u*)(TWS + ((size_t)(g * 128 + s)) * 256 + 8 * oct) = o;
    }
    {
        const int row = 32 * part + (tid >> 4), oct = tid & 15, j = row >> 4, p = row & 15;
        float v[8];
#pragma unroll
        for (int e = 0; e < 8; ++e) { const int si = 8 * oct + e, n = si & 63; const f32x2 c = Cc[p * 65 + n], pk = Pk[(j + 1) * 64 + n];
            v[e] = (si < 64) ? (c.x * pk.x - c.y * pk.y) : -(c.x * pk.y + c.y * pk.x); }
        v4u o; o.x = pk2(v[0], v[1]); o.y = pk2(v[2], v[3]); o.z = pk2(v[4], v[5]); o.w = pk2(v[6], v[7]);
        *(v4u*)(TWY + ((size_t)(g * 256 + row)) * 128 + 8 * oct) = o;
    }
    }
}

constexpr int UPITCH = 528;
constexpr int SSM_U_BYTES = 144 * UPITCH;
struct SampleArgs { const float *B_re, *B_im, *C_re, *C_im, *Dsk, *st_re, *st_im; float *re_s, *im_s; int first, stride; };
__device__ __forceinline__ void ssm_sample_item(int lane, int l, int bs, int g, const bf16* US, bf16* YS, const float* SMT,
        const float* B_re, const float* B_im, const float* C_re, const float* C_im, const float* Dsk, const float* st_re, const float* st_im, float* re_s, float* im_s);
__device__ __forceinline__ void ssm_unit(LAS unsigned char* lds, int tid, int l, int b, int g, const bf16* US, bf16* YS,
        const bf16* TWS, const bf16* TTOEP, const bf16* TWY, const float* SMT, float* re_p, float* im_p, const SampleArgs& sa, volatile LAS unsigned* dbg = nullptr) {
#ifdef DBG_S
    unsigned ts_lo_ = 0;
#define DBGS(i) do { if ((i) + 1 == DBG_S) ts_lo_ = (unsigned)__builtin_amdgcn_s_memrealtime(); if ((i) == DBG_S) { const unsigned t_ = (unsigned)__builtin_amdgcn_s_memrealtime(); if (dbg && threadIdx.x == 0) dbg[0] = t_ - ts_lo_; } } while (0)
#else
#define DBGS(i) do {} while (0)
#endif
    const int wid = __builtin_amdgcn_readfirstlane(tid >> 6), lane = tid & 63, fr = lane & 15, fq = lane >> 4;
    LAS unsigned char* Ul = lds;
    LAS unsigned char* SHl = lds + SSM_U_BYTES + UPITCH;
    LDS_WAIT(); __builtin_amdgcn_s_barrier(); asm volatile("" ::: "memory"); DBGS(-1);
    unsigned z_ = 0u; asm volatile("" : "+v"(z_)); const v4u zv = {z_, z_, z_, z_};
    {
        v4u uv[9];
#pragma unroll
        for (int i = 0; i < 9; ++i) { const int p = tid + 512 * i, tok = p >> 1, half = p & 1; uv[i] = zv;
            if (p < LSEQ * 2) uv[i] = *(const v4u*)(US + ((size_t)(b * LSEQ + tok)) * SW + 16 * g + 8 * half); }
        __builtin_amdgcn_sched_barrier(0);
#pragma unroll
        for (int i = 0; i < 9; ++i) { const int p = tid + 512 * i, tok = p >> 1, half = p & 1;
            if (p < LSEQ * 2) *(LAS v4u*)(Ul + (tok >> 4) * UPITCH + (tok & 15) * 32 + half * 16) = uv[i]; }
    }
    for (int p = tid; p < 15 * 32; p += 512) *(LAS v4u*)(Ul + (129 + (p >> 5)) * UPITCH + (p & 31) * 16) = zv;
    if (tid < 16) *(LAS v4u*)(SHl - UPITCH + tid * 16) = zv;
    const f32x4 sm_scan = *(const f32x4*)(SMT + ((size_t)(l * NG + g) * 64 + lane) * 8 + 4);
    bf16x8 Bf[8];
#pragma unroll
    for (int ks = 0; ks < 8; ++ks) Bf[ks] = *(const bf16x8*)(TWS + ((size_t)(g * 128 + 16 * wid + fr)) * 256 + 32 * ks + 8 * fq);
    LDS_WAIT(); __syncthreads(); DBGS(0);
    {
        for (int mt = 0; mt < 9; ++mt) {
            bf16x8 uf[8];
#pragma unroll
            for (int ks = 0; ks < 8; ++ks) uf[ks] = *(const LAS bf16x8*)(Ul + (16 * mt + fr) * UPITCH + (32 * ks + 8 * fq) * 2);
            __builtin_amdgcn_sched_barrier(0);
            f32x4 a = {0.f, 0.f, 0.f, 0.f}, a2 = {0.f, 0.f, 0.f, 0.f};
#pragma unroll
            for (int ks = 0; ks < 8; ks += 2) { a = __builtin_amdgcn_mfma_f32_16x16x32_bf16(Bf[ks], uf[ks], a, 0, 0, 0); a2 = __builtin_amdgcn_mfma_f32_16x16x32_bf16(Bf[ks + 1], uf[ks + 1], a2, 0, 0, 0); }
            *(LAS f32x4*)(SHl + (16 * mt + fr) * UPITCH + (16 * wid + 4 * fq) * 4) = a + a2;
            __builtin_amdgcn_sched_barrier(0);
        }
    }
    bf16x8 Bt[2][8], By[2][4];
#pragma unroll
    for (int jj = 0; jj < 2; ++jj) { const size_t row = (size_t)(g * 256 + 16 * (2 * wid + jj) + fr);
#pragma unroll
        for (int ks = 0; ks < 8; ++ks) Bt[jj][ks] = *(const bf16x8*)(TTOEP + row * 256 + 32 * ks + 8 * fq);
#pragma unroll
        for (int ks = 0; ks < 4; ++ks) By[jj][ks] = *(const bf16x8*)(TWY + row * 128 + 32 * ks + 8 * fq); }
    LDS_WAIT(); __builtin_amdgcn_s_barrier(); asm volatile("" ::: "memory"); DBGS(1);
    {
        const int n = lane, c0 = 16 * wid, nc = (wid == 7) ? 17 : 16;
        const f32x4 sm = sm_scan;
        const float a16r = sm.x, a16i = sm.y;
        LAS float* Eseg = (LAS float*)(lds + 153600);
        float hr = 0.f, hi = 0.f;
        for (int j0 = 0; j0 < 16; j0 += 4) {
            float sr[4], si[4];
#pragma unroll
            for (int j = 0; j < 4; ++j) { sr[j] = *(const LAS float*)(SHl + (c0 + j0 + j) * UPITCH + n * 4); si[j] = *(const LAS float*)(SHl + (c0 + j0 + j) * UPITCH + (64 + n) * 4); }
            __builtin_amdgcn_sched_barrier(0);
#pragma unroll
            for (int j = 0; j < 4; ++j) { const float nr = a16r * hr - a16i * hi + sr[j], ni = a16r * hi + a16i * hr + si[j]; hr = nr; hi = ni;
                *(LAS float*)(SHl + (c0 + j0 + j) * UPITCH + n * 4) = hr; *(LAS float*)(SHl + (c0 + j0 + j) * UPITCH + (64 + n) * 4) = hi; }
        }
        if (nc == 17) { const float sr = *(const LAS float*)(SHl + 128 * UPITCH + n * 4), si = *(const LAS float*)(SHl + 128 * UPITCH + (64 + n) * 4);
            const float nr = a16r * hr - a16i * hi + sr, ni = a16r * hi + a16i * hr + si; hr = nr; hi = ni;
            *(LAS float*)(SHl + 128 * UPITCH + n * 4) = hr; *(LAS float*)(SHl + 128 * UPITCH + (64 + n) * 4) = hi; }
        Eseg[wid * 128 + n] = hr; Eseg[wid * 128 + 64 + n] = hi;
        LDS_WAIT(); __builtin_amdgcn_s_barrier(); asm volatile("" ::: "memory");
        float p16r = a16r, p16i = a16i;
#pragma unroll
        for (int q = 0; q < 4; ++q) { const float t = p16r * p16r - p16i * p16i; p16i = 2.f * p16r * p16i; p16r = t; }
        float er[7], ei[7];
#pragma unroll
        for (int v = 0; v < 7; ++v) { er[v] = Eseg[v * 128 + n]; ei[v] = Eseg[v * 128 + 64 + n]; }
        float tr = 0.f, ti = 0.f;
#pragma unroll
        for (int v = 0; v < 7; ++v) if (v < wid) { const float nr = p16r * tr - p16i * ti + er[v], ni = p16r * ti + p16i * tr + ei[v]; tr = nr; ti = ni; }
        float pr = a16r, pi = a16i;
        for (int j0 = 0; j0 < 16; j0 += 4) {
            float sr[4], si[4];
#pragma unroll
            for (int j = 0; j < 4; ++j) { sr[j] = *(const LAS float*)(SHl + (c0 + j0 + j) * UPITCH + n * 4); si[j] = *(const LAS float*)(SHl + (c0 + j0 + j) * UPITCH + (64 + n) * 4); }
            __builtin_amdgcn_sched_barrier(0);
#pragma unroll
            for (int j = 0; j < 4; ++j) { hr = sr[j] + (pr * tr - pi * ti); hi = si[j] + (pr * ti + pi * tr);
                *(LAS unsigned short*)(SHl + (c0 + j0 + j) * UPITCH + n * 2) = (unsigned short)f2bf(hr);
                *(LAS unsigned short*)(SHl + (c0 + j0 + j) * UPITCH + (64 + n) * 2) = (unsigned short)f2bf(hi);
                const float t = pr * a16r - pi * a16i; pi = pr * a16i + pi * a16r; pr = t; }
        }
        if (nc == 17) { const float sr = *(const LAS float*)(SHl + 128 * UPITCH + n * 4), si = *(const LAS float*)(SHl + 128 * UPITCH + (64 + n) * 4);
            hr = sr + (pr * tr - pi * ti); hi = si + (pr * ti + pi * tr);
            *(LAS unsigned short*)(SHl + 128 * UPITCH + n * 2) = (unsigned short)f2bf(hr); *(LAS unsigned short*)(SHl + 128 * UPITCH + (64 + n) * 2) = (unsigned short)f2bf(hi);
            re_p[((size_t)(b * NG + g)) * 64 + n] = hr; im_p[((size_t)(b * NG + g)) * 64 + n] = hi; }
    }
    LDS_WAIT(); __builtin_amdgcn_s_barrier(); asm volatile("" ::: "memory"); DBGS(2);
    {
#define SSM_LD2(mt_) do { _Pragma("unroll") for (int ks = 0; ks < 8; ++ks) uf[ks] = *(const LAS bf16x8*)(Ul + (16 * (mt_) + fr) * UPITCH + (32 * ks + 8 * fq) * 2); \
            _Pragma("unroll") for (int ks = 0; ks < 4; ++ks) hf[ks] = *(const LAS bf16x8*)(SHl - UPITCH + (16 * (mt_) + fr) * UPITCH + (32 * ks + 8 * fq) * 2); } while (0)
#define SSM_MM2() do { a0 = (f32x4){0.f, 0.f, 0.f, 0.f}; a1 = (f32x4){0.f, 0.f, 0.f, 0.f}; \
            _Pragma("unroll") for (int ks = 0; ks < 8; ++ks) { a0 = __builtin_amdgcn_mfma_f32_16x16x32_bf16(Bt[0][ks], uf[ks], a0, 0, 0, 0); a1 = __builtin_amdgcn_mfma_f32_16x16x32_bf16(Bt[1][ks], uf[ks], a1, 0, 0, 0); } \
            _Pragma("unroll") for (int ks = 0; ks < 4; ++ks) { a0 = __builtin_amdgcn_mfma_f32_16x16x32_bf16(By[0][ks], hf[ks], a0, 0, 0, 0); a1 = __builtin_amdgcn_mfma_f32_16x16x32_bf16(By[1][ks], hf[ks], a1, 0, 0, 0); } } while (0)
#define SSM_MM2E() do { a0 = (f32x4){0.f, 0.f, 0.f, 0.f}; a1 = (f32x4){0.f, 0.f, 0.f, 0.f}; f32x2 cc[4], qq[4], rr[4]; \
            const f32x2 K1 = {-2.302208198f, -2.302208198f}, K2 = {-0.102943240f, -0.102943240f}, one = {1.f, 1.f}; \
            _Pragma("unroll") for (int sl = 0; sl < 12; ++sl) { \
                if (sl < 8) { a0 = __builtin_amdgcn_mfma_f32_16x16x32_bf16(Bt[0][sl], uf[sl], a0, 0, 0, 0); a1 = __builtin_amdgcn_mfma_f32_16x16x32_bf16(Bt[1][sl], uf[sl], a1, 0, 0, 0); } \
                else { a0 = __builtin_amdgcn_mfma_f32_16x16x32_bf16(By[0][sl - 8], hf[sl - 8], a0, 0, 0, 0); a1 = __builtin_amdgcn_mfma_f32_16x16x32_bf16(By[1][sl - 8], hf[sl - 8], a1, 0, 0, 0); } \
                const int pq = sl / 3, st = sl % 3; \
                if (st == 0) { cc[pq] = pr2(pq < 2 ? p0 : p1, pq & 1); qq[pq] = cc[pq] * __builtin_elementwise_fma(cc[pq] * cc[pq], K2, K1); } \
                else if (st == 1) { f32x2 e; e.x = __builtin_amdgcn_exp2f(qq[pq].x); e.y = __builtin_amdgcn_exp2f(qq[pq].y); const f32x2 d = e + one; rr[pq].x = __builtin_amdgcn_rcpf(d.x); rr[pq].y = __builtin_amdgcn_rcpf(d.y); } \
                else { cc[pq] = cc[pq] * rr[pq]; } \
                __builtin_amdgcn_sched_barrier(0); } \
            o0.x = pg8::cvt_pk_bf16(cc[0].x, cc[0].y); o0.y = pg8::cvt_pk_bf16(cc[1].x, cc[1].y); o1.x = pg8::cvt_pk_bf16(cc[2].x, cc[2].y); o1.y = pg8::cvt_pk_bf16(cc[3].x, cc[3].y); } while (0)
#define SSM_ST2(mt_) do { const int c = 16 * (mt_) + fr; \
            if (c < 129) { const size_t row = (size_t)(b * LSEQ + 16 * c + 2 * wid); *(v2u*)(YS + row * SW + 16 * g + 4 * fq) = o0; *(v2u*)(YS + (row + 1) * SW + 16 * g + 4 * fq) = o1; } } while (0)
        bf16x8 uf[8], hf[4]; f32x4 a0, a1, p0, p1; v2u o0, o1;
        SSM_LD2(0); __builtin_amdgcn_sched_barrier(0); SSM_MM2(); __builtin_amdgcn_sched_barrier(0); p0 = a0; p1 = a1;
#pragma unroll 1
        for (int mt = 1; mt < 9; ++mt) {
            SSM_LD2(mt); __builtin_amdgcn_sched_barrier(0);
            SSM_MM2E(); SSM_ST2(mt - 1);
            __builtin_amdgcn_sched_barrier(0); p0 = a0; p1 = a1;
        }
        {
            const f32x2 e0 = gelu2(pr2(p0, 0)), e1 = gelu2(pr2(p0, 1)), e2 = gelu2(pr2(p1, 0)), e3 = gelu2(pr2(p1, 1));
            o0.x = pg8::cvt_pk_bf16(e0.x, e0.y); o0.y = pg8::cvt_pk_bf16(e1.x, e1.y); o1.x = pg8::cvt_pk_bf16(e2.x, e2.y); o1.y = pg8::cvt_pk_bf16(e3.x, e3.y);
            SSM_ST2(8);
        }
#undef SSM_MM2E
#undef SSM_ST2
#undef SSM_LD2
#undef SSM_MM2
    }
    LDS_WAIT(); __builtin_amdgcn_s_barrier(); asm volatile("" ::: "memory"); DBGS(3);
}

template <int NSMP>
__device__ __forceinline__ void ssm_sample_items(int lane, int l, int bs0, int dbs, int g, const bf16* US, bf16* YS, const float* SMT,
        const float* B_re, const float* B_im, const float* C_re, const float* C_im, const float* Dsk, const float* st_re, const float* st_im, float* re_s, float* im_s) {
    const int n = lane, lg = l * NG + g;
    const f32x4 sm = *(const f32x4*)(SMT + ((size_t)lg * 64 + n) * 8);
    const float* brp = B_re + ((size_t)lg * 64 + n) * 16; const float* bip = B_im + ((size_t)lg * 64 + n) * 16;
    f32x4 br[4], bi[4];
#pragma unroll
    for (int q4 = 0; q4 < 4; ++q4) { br[q4] = *(const f32x4*)(brp + 4 * q4); bi[q4] = *(const f32x4*)(bip + 4 * q4); }
    float cr[16], ci[16];
#pragma unroll
    for (int p = 0; p < 16; ++p) { cr[p] = C_re[((size_t)lg * 16 + p) * 64 + n]; ci[p] = C_im[((size_t)lg * 16 + p) * 64 + n]; }
    const int pme = ((lane >> 5) & 1) * 8 + ((lane >> 4) & 1) * 4 + ((lane >> 3) & 1) * 2 + ((lane >> 2) & 1);
    const float dme = Dsk[l * SW + 16 * g + pme];
    v4u u0[NSMP], u1[NSMP]; float h0r[NSMP], h0i[NSMP], ume[NSMP]; size_t so[NSMP];
#pragma unroll
    for (int k = 0; k < NSMP; ++k) { const int bs = bs0 + k * dbs; const bf16* up = US + ((size_t)(MP + bs)) * SW + 16 * g; u0[k] = *(const v4u*)up; u1[k] = *(const v4u*)(up + 8); ume[k] = bflo((unsigned)up[pme]);
        so[k] = ((size_t)((l * NS + bs) * NG + g)) * 64 + n; h0r[k] = st_re[so[k]]; h0i[k] = st_im[so[k]]; }
    __builtin_amdgcn_sched_barrier(0);
    float v[NSMP][16];
#pragma unroll
    for (int k = 0; k < NSMP; ++k) {
        float uu[16]; { float t8[8]; unpack8(u0[k], t8);
#pragma unroll
          for (int e = 0; e < 8; ++e) uu[e] = t8[e];
          unpack8(u1[k], t8);
#pragma unroll
          for (int e = 0; e < 8; ++e) uu[8 + e] = t8[e]; }
        float sr = 0.f, si = 0.f;
#pragma unroll
        for (int q4 = 0; q4 < 4; ++q4)
#pragma unroll
            for (int j = 0; j < 4; ++j) { sr += br[q4][j] * uu[4 * q4 + j]; si += bi[q4][j] * uu[4 * q4 + j]; }
        const float hr = sm.x * h0r[k] - sm.y * h0i[k] + (sm.z * sr - sm.w * si), hi = sm.x * h0i[k] + sm.y * h0r[k] + (sm.z * si + sm.w * sr);
        re_s[so[k]] = hr; im_s[so[k]] = hi;
#pragma unroll
        for (int p = 0; p < 16; ++p) v[k][p] = cr[p] * hr - ci[p] * hi;
    }
    { const bool hi32 = (lane & 32) != 0;
#pragma unroll
      for (int i = 0; i < 8; ++i)
#pragma unroll
        for (int k = 0; k < NSMP; ++k) { const float snd = hi32 ? v[k][i] : v[k][8 + i], keep = hi32 ? v[k][8 + i] : v[k][i]; v[k][i] = keep + __shfl_xor(snd, 32); } }
    { const bool hb = (lane & 16) != 0;
#pragma unroll
      for (int i = 0; i < 4; ++i)
#pragma unroll
        for (int k = 0; k < NSMP; ++k) { const float snd = hb ? v[k][i] : v[k][4 + i], keep = hb ? v[k][4 + i] : v[k][i]; v[k][i] = keep + __shfl_xor(snd, 16); } }
    { const bool hb = (lane & 8) != 0;
#pragma unroll
      for (int i = 0; i < 2; ++i)
#pragma unroll
        for (int k = 0; k < NSMP; ++k) { const float snd = hb ? v[k][i] : v[k][2 + i], keep = hb ? v[k][2 + i] : v[k][i]; v[k][i] = keep + __shfl_xor(snd, 8); } }
    { const bool hb = (lane & 4) != 0;
#pragma unroll
      for (int k = 0; k < NSMP; ++k) { const float snd = hb ? v[k][0] : v[k][1], keep = hb ? v[k][1] : v[k][0]; v[k][0] = keep + __shfl_xor(snd, 4); } }
#pragma unroll
    for (int k = 0; k < NSMP; ++k) v[k][0] += __shfl_xor(v[k][0], 2);
#pragma unroll
    for (int k = 0; k < NSMP; ++k) v[k][0] += __shfl_xor(v[k][0], 1);
    if ((lane & 3) == 0) {
#pragma unroll
        for (int k = 0; k < NSMP; ++k) YS[((size_t)(MP + bs0 + k * dbs)) * SW + 16 * g + pme] = (bf16)f2bf(gelu_t(v[k][0] + dme * ume[k])); }
}
__device__ __forceinline__ void ssm_sample_item(int lane, int l, int bs, int g, const bf16* US, bf16* YS, const float* SMT,
        const float* B_re, const float* B_im, const float* C_re, const float* C_im, const float* Dsk, const float* st_re, const float* st_im, float* re_s, float* im_s) {
    ssm_sample_items<1>(lane, l, bs, 0, g, US, YS, SMT, B_re, B_im, C_re, C_im, Dsk, st_re, st_im, re_s, im_s);
}

constexpr int PPITCH = 272;
__device__ __forceinline__ void pool_unit(LAS unsigned char* lds, int tid, int pm, int grp, const bf16* UP, bf16* GP, const bf16* WPOOL, const float* hs) {
    const int wid = __builtin_amdgcn_readfirstlane(tid >> 6), lane = tid & 63, wr = wid >> 2, wc = wid & 3, fr = lane & 15, fq = lane >> 4;
    LAS unsigned char* Ut = lds; LAS unsigned char* Dt = lds + 73728;
    const int r0 = pm * 256, w = 2 << grp;
    LDS_WAIT(); __builtin_amdgcn_s_barrier(); asm volatile("" ::: "memory");
    unsigned z_ = 0u; asm volatile("" : "+v"(z_)); const v4u zv = {z_, z_, z_, z_};
    bf16x8 Bf[2][2][4]; v4u gwa[2][4][2];
#pragma unroll
    for (int bj = 0; bj < 2; ++bj)
#pragma unroll
        for (int n = 0; n < 2; ++n) { const int prow = 128 * bj + 32 * wc + 8 * (fr >> 2) + 4 * n + (fr & 3);
#pragma unroll
            for (int ks = 0; ks < 4; ++ks) Bf[bj][n][ks] = *(const bf16x8*)(WPOOL + ((size_t)(grp * 256 + prow)) * 128 + 32 * ks + 8 * fq); }
#pragma unroll
    for (int ai = 0; ai < 2; ++ai)
#pragma unroll
        for (int m = 0; m < 4; ++m)
#pragma unroll
            for (int bj = 0; bj < 2; ++bj) gwa[ai][m][bj] = *(const v4u*)(GP + (size_t)(r0 + 128 * ai + 64 * wr + 16 * m + fr) * D + 256 * grp + 128 * bj + 32 * wc + 8 * fq);
    {
        v4u uv[9];
#pragma unroll
        for (int i = 0; i < 9; ++i) { const int it = tid + 512 * i, rr = it >> 4, oct = it & 15, r = r0 - 15 + rr; uv[i] = zv;
            if (it < 271 * 16 && r >= 0) uv[i] = *(const v4u*)(UP + (size_t)r * PW + 128 * grp + 8 * oct); }
        __builtin_amdgcn_sched_barrier(0);
#pragma unroll
        for (int i = 0; i < 9; ++i) { const int it = tid + 512 * i, rr = it >> 4, oct = it & 15;
            if (it < 271 * 16) *(LAS v4u*)(Ut + rr * PPITCH + oct * 16) = uv[i]; }
    }
    LDS_WAIT(); __syncthreads();
    const bool plain = (r0 >= 15) && (r0 + 255 < MP) && ((r0 - 15) / LSEQ == (r0 + 255) / LSEQ);
    if (plain) {
        const int seg = tid >> 4, oct = tid & 15, row0 = 8 * seg; const float inv = 1.0f / (float)w;
        float sw[8], x[8];
#pragma unroll
        for (int e = 0; e < 8; ++e) sw[e] = 0.f;
        for (int i = 1; i < w; ++i) { unpack8(*(const LAS v4u*)(Ut + (row0 + 15 - i) * PPITCH + oct * 16), x);
#pragma unroll
            for (int e = 0; e < 8; ++e) sw[e] += x[e]; }
#pragma unroll
        for (int k = 0; k < 8; ++k) { const int row = row0 + k; float self[8];
            unpack8(*(const LAS v4u*)(Ut + (row + 15) * PPITCH + oct * 16), self);
            unpack8(*(const LAS v4u*)(Ut + (row + 16 - w) * PPITCH + oct * 16), x);
#pragma unroll
            for (int e = 0; e < 8; ++e) { sw[e] += self[e]; const float dv = sw[e] * inv - self[e]; sw[e] -= x[e]; x[e] = dv; }
            *(LAS v4u*)(Dt + row * PPITCH + oct * 16) = pack8(x); }
    } else if (r0 + 255 < MP) {
        const int seg = tid >> 4, oct = tid & 15, row0 = 8 * seg; int t = (r0 + row0) % LSEQ;
        float sw[8], x[8];
#pragma unroll
        for (int e = 0; e < 8; ++e) sw[e] = 0.f;
        for (int i = 1; i < w; ++i) if (i <= t) { unpack8(*(const LAS v4u*)(Ut + (row0 + 15 - i) * PPITCH + oct * 16), x);
#pragma unroll
            for (int e = 0; e < 8; ++e) sw[e] += x[e]; }
#pragma unroll
        for (int k = 0; k < 8; ++k) { const int row = row0 + k; float self[8];
            unpack8(*(const LAS v4u*)(Ut + (row + 15) * PPITCH + oct * 16), self);
            const int nav = (t + 1 < w) ? (t + 1) : w; const float inv = 1.0f / (float)nav; const bool full = (t + 1 >= w);
            unpack8(*(const LAS v4u*)(Ut + (row + 16 - w) * PPITCH + oct * 16), x);
#pragma unroll
            for (int e = 0; e < 8; ++e) { const float sb = (t == 0) ? 0.f : sw[e]; const float sn = sb + self[e]; const float dv = sn * inv - self[e]; sw[e] = full ? sn - x[e] : sn; x[e] = dv; }
            *(LAS v4u*)(Dt + row * PPITCH + oct * 16) = pack8(x);
            t = (t + 1 == LSEQ) ? 0 : t + 1; }
    } else
    for (int it = tid; it < 4096; it += 512) {
        const int row = it >> 4, oct = it & 15, r = r0 + row;
        float self[8], sum[8], x[8]; float inv;
        unpack8(*(const LAS v4u*)(Ut + (row + 15) * PPITCH + oct * 16), self);
#pragma unroll
        for (int e = 0; e < 8; ++e) sum[e] = self[e];
        if (r < MP) { const int t = r % LSEQ; const int nav = (t + 1 < w) ? (t + 1) : w;
            for (int i = 1; i < nav; ++i) { unpack8(*(const LAS v4u*)(Ut + (row + 15 - i) * PPITCH + oct * 16), x);
#pragma unroll
                for (int e = 0; e < 8; ++e) sum[e] += x[e]; }
            inv = 1.0f / (float)nav;
        } else { const float* h = hs + ((size_t)(r - MP)) * PW + 128 * grp + 8 * oct; const f32x4 a = *(const f32x4*)h, c = *(const f32x4*)(h + 4);
#pragma unroll
            for (int e = 0; e < 4; ++e) { sum[e] += a[e]; sum[4 + e] += c[e]; }
            inv = 1.0f / (float)w;
        }
#pragma unroll
        for (int e = 0; e < 8; ++e) x[e] = sum[e] * inv - self[e];
        *(LAS v4u*)(Dt + row * PPITCH + oct * 16) = pack8(x);
    }
    LDS_WAIT(); __syncthreads();
#pragma unroll
    for (int ai = 0; ai < 2; ++ai)
#pragma unroll
        for (int m = 0; m < 4; ++m) {
            f32x4 a[2][2];
#pragma unroll
            for (int bj = 0; bj < 2; ++bj)
#pragma unroll
                for (int n = 0; n < 2; ++n) a[bj][n] = (f32x4){0.f, 0.f, 0.f, 0.f};
            const int row = 128 * ai + 64 * wr + 16 * m + fr, r = r0 + row;
            bf16x8 df[4];
#pragma unroll
            for (int ks = 0; ks < 4; ++ks) df[ks] = *(const LAS bf16x8*)(Dt + row * PPITCH + (32 * ks + 8 * fq) * 2);
            __builtin_amdgcn_sched_barrier(0);
#pragma unroll
            for (int ks = 0; ks < 4; ++ks)
#pragma unroll
                for (int bj = 0; bj < 2; ++bj)
#pragma unroll
                    for (int n = 0; n < 2; ++n) a[bj][n] = __builtin_amdgcn_mfma_f32_16x16x32_bf16(Bf[bj][n][ks], df[ks], a[bj][n], 0, 0, 0);
#pragma unroll
            for (int bj = 0; bj < 2; ++bj) { bf16* p = GP + (size_t)r * D + 256 * grp + 128 * bj + 32 * wc + 8 * fq; float gv[8], o[8]; unpack8(gwa[ai][m][bj], gv);
#pragma unroll
                for (int n = 0; n < 2; ++n)
#pragma unroll
                    for (int j = 0; j < 4; ++j) o[4 * n + j] = gv[4 * n + j] * a[bj][n][j];
                *(v4u*)p = pack8(o); }
        }
}

__device__ __forceinline__ void pool_mini8(LAS unsigned char* lds, int tid, int rbase, int grp, const bf16* UP, bf16* GP, const bf16* WPOOL, const float* hs) {
    const int wid = __builtin_amdgcn_readfirstlane(tid >> 6), lane = tid & 63, fr = lane & 15, fq = lane >> 4, w = 2 << grp;
    constexpr int DP = 272;
    LDS_WAIT(); __builtin_amdgcn_s_barrier(); asm volatile("" ::: "memory");
    bf16x8 bw[2][4]; v2u gw[2];
#pragma unroll
    for (int q = 0; q < 2; ++q)
#pragma unroll
        for (int ks = 0; ks < 4; ++ks) bw[q][ks] = *(const bf16x8*)(WPOOL + ((size_t)(grp * 256 + 16 * (2 * wid + q) + fr)) * 128 + 32 * ks + 8 * fq);
    bf16* gp = GP + (size_t)(rbase + fr) * D + 256 * grp + 32 * wid + 4 * fq;
#pragma unroll
    for (int q = 0; q < 2; ++q) gw[q] = *(const v2u*)(gp + 16 * q);
    {
        const int row = tid >> 5, oct = (tid >> 1) & 15, h = tid & 1, rr = rbase + row;
        const bf16* up = UP + (size_t)rr * PW + 128 * grp + 8 * oct;
        float self[8], sum[8]; float inv;
        unpack8(*(const v4u*)up, self);
#pragma unroll
        for (int e = 0; e < 8; ++e) sum[e] = (h == 0) ? self[e] : 0.f;
        if (rr < MP) { const int t = rr % LSEQ; const int nav = (t + 1 < w) ? (t + 1) : w;
            v4u xv[8];
#pragma unroll
            for (int k = 0; k < 8; ++k) { const int i = 1 + h + 2 * k; xv[k] = *(const v4u*)(up - (size_t)((i < w) ? i : 0) * PW); }
            __builtin_amdgcn_sched_barrier(0);
#pragma unroll
            for (int k = 0; k < 8; ++k) { const int i = 1 + h + 2 * k; const float mk = (i < nav) ? 1.0f : 0.0f; float x[8]; unpack8(xv[k], x);
#pragma unroll
                for (int e = 0; e < 8; ++e) sum[e] += mk * x[e]; }
            inv = 1.0f / (float)nav;
        } else {
            if (h == 0) { const float* hp = hs + ((size_t)(rr - MP)) * PW + 128 * grp + 8 * oct; const f32x4 a = *(const f32x4*)hp, c = *(const f32x4*)(hp + 4);
#pragma unroll
                for (int e = 0; e < 4; ++e) { sum[e] += a[e]; sum[4 + e] += c[e]; } }
            inv = 1.0f / (float)w; }
#pragma unroll
        for (int e = 0; e < 8; ++e) sum[e] += __shfl_xor(sum[e], 1);
        if (h == 0) { float x[8];
#pragma unroll
            for (int e = 0; e < 8; ++e) x[e] = sum[e] * inv - self[e];
            *(LAS v4u*)(lds + row * DP + oct * 16) = pack8(x); }
    }
    LDS_WAIT(); __syncthreads();
    bf16x8 df[4];
#pragma unroll
    for (int ks = 0; ks < 4; ++ks) df[ks] = *(const LAS bf16x8*)(lds + fr * DP + (32 * ks + 8 * fq) * 2);
#pragma unroll
    for (int q = 0; q < 2; ++q) {
        f32x4 a = {0.f, 0.f, 0.f, 0.f};
#pragma unroll
        for (int ks = 0; ks < 4; ++ks) a = __builtin_amdgcn_mfma_f32_16x16x32_bf16(bw[q][ks], df[ks], a, 0, 0, 0);
        v2u o; o.x = pg8::cvt_pk_bf16(bflo(gw[q].x) * a[0], bfhi(gw[q].x) * a[1]); o.y = pg8::cvt_pk_bf16(bflo(gw[q].y) * a[2], bfhi(gw[q].y) * a[3]);
        *(v2u*)(gp + 16 * q) = o;
    }
}

__device__ __forceinline__ void pool_mini(int lane, int rbase, int grp, const bf16* UP, bf16* GP, const bf16* WPOOL, const float* hs) {
    const int fr = lane & 15, fq = lane >> 4, r = rbase + fr, w = 2 << grp;
    bf16x8 df[4];
    {
        const int col0 = 128 * grp + 8 * fq;
        float self[4][8], sum[4][8]; float inv;
#pragma unroll
        for (int ks = 0; ks < 4; ++ks) { unpack8(*(const v4u*)(UP + (size_t)r * PW + col0 + 32 * ks), self[ks]);
#pragma unroll
            for (int e = 0; e < 8; ++e) sum[ks][e] = self[ks][e]; }
        if (r < MP) { const int t = r % LSEQ; const int nav = (t + 1 < w) ? (t + 1) : w;
#pragma unroll 3
            for (int i = 1; i < w; ++i) {
                v4u xv[4];
#pragma unroll
                for (int ks = 0; ks < 4; ++ks) xv[ks] = *(const v4u*)(UP + (size_t)(r - i) * PW + col0 + 32 * ks);
                __builtin_amdgcn_sched_barrier(0);
                const float mk = (i < nav) ? 1.0f : 0.0f;
#pragma unroll
                for (int ks = 0; ks < 4; ++ks) { float x[8]; unpack8(xv[ks], x);
#pragma unroll
                    for (int e = 0; e < 8; ++e) sum[ks][e] += mk * x[e]; }
            }
            inv = 1.0f / (float)nav;
        } else {
#pragma unroll
            for (int ks = 0; ks < 4; ++ks) { const float* h = hs + ((size_t)(r - MP)) * PW + col0 + 32 * ks; const f32x4 a = *(const f32x4*)h, c = *(const f32x4*)(h + 4);
#pragma unroll
                for (int e = 0; e < 4; ++e) { sum[ks][e] += a[e]; sum[ks][4 + e] += c[e]; } }
            inv = 1.0f / (float)w; }
#pragma unroll
        for (int ks = 0; ks < 4; ++ks) { float x[8];
#pragma unroll
            for (int e = 0; e < 8; ++e) x[e] = sum[ks][e] * inv - self[ks][e];
            const v4u pk = pack8(x); df[ks] = __builtin_bit_cast(bf16x8, pk); }
    }
    for (int nt = 0; nt < 16; nt += 2) {
        bf16x8 bw[2][4];
#pragma unroll
        for (int q = 0; q < 2; ++q)
#pragma unroll
            for (int ks = 0; ks < 4; ++ks) bw[q][ks] = *(const bf16x8*)(WPOOL + ((size_t)(grp * 256 + 16 * (nt + q) + fr)) * 128 + 32 * ks + 8 * fq);
#pragma unroll
        for (int q = 0; q < 2; ++q) {
            f32x4 a = {0.f, 0.f, 0.f, 0.f};
#pragma unroll
            for (int ks = 0; ks < 4; ++ks) a = __builtin_amdgcn_mfma_f32_16x16x32_bf16(bw[q][ks], df[ks], a, 0, 0, 0);
            bf16* p = GP + (size_t)r * D + 256 * grp + 16 * (nt + q) + 4 * fq; const v2u gw = *(const v2u*)p;
            v2u o; o.x = pg8::cvt_pk_bf16(bflo(gw.x) * a[0], bfhi(gw.x) * a[1]); o.y = pg8::cvt_pk_bf16(bflo(gw.y) * a[2], bfhi(gw.y) * a[3]);
            *(v2u*)p = o;
        }
    }
}

__device__ __forceinline__ void act_fixup(int tid, int pm, bf16* ACT, const float* cw, const float* cb, const float* Gtop, const float* Vtop, const float* Gbot) {
    constexpr int NIT = 2 * (DFF / 4), NK = (NIT + 511) / 512;
    f32x4 g0[NK], vv[NK], b1[NK], b0[NK], t0[NK], w0[NK], w1[NK], w2[NK], bb[NK];
#pragma unroll
    for (int k = 0; k < NK; ++k) { const int it_ = tid + 512 * k, it = (it_ < NIT) ? it_ : NIT - 1; const int e = it / (DFF / 4), c4 = (it % (DFF / 4)) * 4;
        g0[k] = *(const f32x4*)(Gtop + ((size_t)(pm * 2 + e)) * DFF + c4); vv[k] = *(const f32x4*)(Vtop + ((size_t)(pm * 2 + e)) * DFF + c4);
        b1[k] = *(const f32x4*)(Gbot + ((size_t)((pm - 1) * 2 + 1)) * DFF + c4); b0[k] = *(const f32x4*)(Gbot + ((size_t)((pm - 1) * 2 + 0)) * DFF + c4); t0[k] = *(const f32x4*)(Gtop + ((size_t)(pm * 2)) * DFF + c4);
        w0[k] = *(const f32x4*)(cw + c4); w1[k] = *(const f32x4*)(cw + DFF + c4); w2[k] = *(const f32x4*)(cw + 2 * DFF + c4); bb[k] = *(const f32x4*)(cb + c4); }
    __builtin_amdgcn_sched_barrier(0);
#pragma unroll
    for (int k = 0; k < NK; ++k) { const int it = tid + 512 * k;
        if (it < NIT) { const int e = it / (DFF / 4), c4 = (it % (DFF / 4)) * 4, r = pm * 256 + e, t = r % LSEQ;
            f32x4 g1 = (e == 1) ? t0[k] : b1[k], g2 = (e == 1) ? b1[k] : b0[k];
            if (t == 0) g1 = (f32x4){0.f, 0.f, 0.f, 0.f};
            if (t <= 1) g2 = (f32x4){0.f, 0.f, 0.f, 0.f};
            float o[4];
#pragma unroll
            for (int j = 0; j < 4; ++j) o[j] = gelu_t(bb[k][j] + w0[k][j] * g2[j] + w1[k][j] * g1[j] + w2[k][j] * g0[k][j]) * vv[k][j];
            v2u w; w.x = pg8::cvt_pk_bf16(o[0], o[1]); w.y = pg8::cvt_pk_bf16(o[2], o[3]);
            *(v2u*)(ACT + (size_t)r * DFF + c4) = w; } }
}

constexpr size_t O_YP = 0, O_YS = O_YP + (size_t)NB * SEQ * D, O_POOLP = O_YS + (size_t)NS * D, O_REP = O_POOLP + (size_t)DEPTH * NB * PHIST * PW,
                 O_IMP = O_REP + (size_t)DEPTH * NB * NG * NST, O_CONVP = O_IMP + (size_t)DEPTH * NB * NG * NST, O_POOLS = O_CONVP + (size_t)DEPTH * NB * 2 * DFF,
                 O_RES = O_POOLS + (size_t)DEPTH * NS * PHIST * PW, O_IMS = O_RES + (size_t)DEPTH * NS * NG * NST, O_CONVS = O_IMS + (size_t)DEPTH * NS * NG * NST,
                 O_END = O_CONVS + (size_t)DEPTH * NS * 2 * DFF;
static_assert(O_END == 21643264, "output size");

enum { I_XP = 0, I_XS, I_SPOOL, I_SRE, I_SIM, I_SCONV, I_META, I_N1G, I_WIN, I_POOLW, I_POOLSC, I_ARE, I_AIM, I_LOGDT, I_BRE, I_BIM, I_CRE, I_CIM, I_DSK, I_WGLU, I_WOUT, I_N2G, I_WUP, I_CONVW, I_CONVB, I_WDOWN, I_NFG, N_IN };

struct Args { const float* in[N_IN]; float* out; unsigned char* ws; unsigned long long pad; };

constexpr int NWAVES = 8;
__global__ void __launch_bounds__(NWAVES * 64, 2) mk_fwd(Args args) {
    extern __shared__ __attribute__((aligned(16))) unsigned char lds_raw[];
    LAS unsigned char* lds = (LAS unsigned char*)lds_raw;
    volatile LAS unsigned* MISC = (volatile LAS unsigned*)(lds + MISC_OFF);
    const int tid = threadIdx.x, lane = tid & 63, wave = __builtin_amdgcn_readfirstlane(tid >> 6);
    const int G = gridDim.x, bx = blockIdx.x;
    const char __attribute__((address_space(4)))* kargs = (const char __attribute__((address_space(4)))*)__builtin_amdgcn_kernarg_segment_ptr();
#define INP(i) ([&]() { const float GAS* p_; asm volatile("s_load_dwordx2 %0, %1, %2\n\ts_waitcnt lgkmcnt(0)" : "=s"(p_) : "s"(kargs), "i"(8 * (i)) : "memory"); return (const float*)p_; }())
    unsigned char* ws = args.ws; float* out = args.out;
    for (int u = tid; u < (LDS_BYTES - LDSCTL_OFF) / 4; u += NWAVES * 64) ((LAS unsigned*)(lds + LDSCTL_OFF))[u] = 0u;
    __syncthreads();
    XcdBarrier bar = xcd_barrier_post((unsigned*)(ws + WS_CTL) + CW_BAR, MISC + 8);
#ifdef TS_I
    int n_stamp_ = 0;
#define STAMP() do { if (threadIdx.x == 0) { const unsigned long long t_ = __builtin_amdgcn_s_memrealtime(); MISC[16 + 2 * n_stamp_] = (unsigned)t_; MISC[17 + 2 * n_stamp_] = (unsigned)(t_ >> 32); } ++n_stamp_; } while (0)
#else
#define STAMP() do {} while (0)
#endif
#ifdef BAR_DELAY
#define GRID_BAR() do { xcd_barrier(bar); { const unsigned long long t0_ = __builtin_amdgcn_s_memrealtime(); while (__builtin_amdgcn_s_memrealtime() - t0_ < BAR_DELAY) __builtin_amdgcn_s_sleep(8); } __syncthreads(); } while (0)
#else
#ifdef DOUBLE_BAR
#define GRID_BAR() do { xcd_barrier(bar); xcd_barrier(bar); STAMP(); } while (0)
#else
#define GRID_BAR() do { xcd_barrier(bar); STAMP(); } while (0)
#endif
#endif
#ifdef GEMM_DBG
#define DBGP(c) (((c) == GEMM_DBG && l == 0) ? (MISC + 50) : (volatile LAS unsigned*)nullptr)
#else
#define DBGP(c) ((volatile LAS unsigned*)nullptr)
#endif
#define OPAQUE_TID() int ptid = threadIdx.x; asm volatile("" : "+v"(ptid)); const int plane = ptid & 63; (void)plane

    STAMP();
    float* RS = (float*)(ws + WS_RS); float* RSX = (float*)(ws + WS_RSX); float* SMT = (float*)(ws + WS_SM);
    float* Gtop = (float*)(ws + WS_GTOP); float* Vtop = (float*)(ws + WS_VTOP); float* Gbot = (float*)(ws + WS_GBOT);
    bf16* XB = (bf16*)(ws + WS_XB); bf16* YSB = (bf16*)(ws + WS_YS);
    bf16* UPB = (bf16*)(ws + WS_UP); bf16* USB = (bf16*)(ws + WS_US); bf16* GP = (bf16*)(ws + WS_GP); bf16* GS = (bf16*)(ws + WS_GS); bf16* ACT = (bf16*)(ws + WS_ACT);
    const int gw = bx * NWAVES + wave, NGW = G * NWAVES;

#ifndef PH_MASK
#define PH_MASK 0xFFFF
#endif
#define PH(k) ((PH_MASK >> (k)) & 1)
    constexpr int I_IN = (D / 64) * (NIN / 64), I_GLU = (SW / 64) * (2 * D / 64), I_OUT = (D / 64) * (D / 64), I_UP = (D / 64) * (NUP / 64), I_DOWN = (DFF / 64) * (D / 64), I_PL = (128 / 64) * (256 / 64);
    constexpr int NITEMS = I_IN + I_GLU + I_OUT + I_UP + I_DOWN + 4 * I_PL;
    constexpr int NWG_E = (M / 256) * (NUP / 256);
    const int e_rem = NWG_E % G, e_idle = G - e_rem;
    const bool fuse_final = (MMAIN / 256) * (D / 256) <= G;
    const bool defer_l1 = e_rem != 0 && e_idle * 4 >= G;
#ifdef DBG_P
    unsigned long long tp_ = __builtin_amdgcn_s_memrealtime();
#define DBGT(i) do { __syncthreads(); const unsigned long long t_ = __builtin_amdgcn_s_memrealtime(); if (threadIdx.x == 0) MISC[54 + (i)] = (unsigned)(t_ - tp_); tp_ = t_; } while (0)
#else
#define DBGT(i) do {} while (0)
#endif
    if (PH(0)) {
    OPAQUE_TID(); const int pgw = bx * NWAVES + __builtin_amdgcn_readfirstlane(ptid >> 6);
    for (int m = pgw; m < M; m += NGW) {
        const float* src;
        if (m < MP) { const int b = m / LSEQ, t = m - b * LSEQ; src = (t < NMETA) ? INP(I_META) + (size_t)t * D : INP(I_XP) + ((size_t)(b * SEQ + t - NMETA)) * D; }
        else src = INP(I_XS) + (size_t)(m - MP) * D;
        const f32x4* s4 = (const f32x4*)src + plane; f32x4 v[4]; float ss = 0.f;
#pragma unroll
        for (int j = 0; j < 4; ++j) v[j] = __builtin_nontemporal_load(s4 + 64 * j);
        unsigned long long* o8 = (unsigned long long*)(XB + (size_t)m * D) + plane;
#pragma unroll
        for (int j = 0; j < 4; ++j) { const unsigned lo = pk2(v[j].x, v[j].y), hi = pk2(v[j].z, v[j].w); o8[64 * j] = (unsigned long long)lo | ((unsigned long long)hi << 32);
            const float a0 = bflo(lo), a1 = bfhi(lo), a2 = bflo(hi), a3 = bfhi(hi); ss += (a0 * a0 + a1 * a1) + (a2 * a2 + a3 * a3); }
        ss = wave_sum(ss);
        if (m < MMAIN) { if (plane < 16) RS[(size_t)m * 16 + plane] = (plane == 0) ? ss : 0.f; } else if (plane < 32) RSX[(size_t)(m - MMAIN) * 32 + plane] = (plane == 0) ? ss : 0.f;
    }
    DBGT(0);
    {
        const int gt = bx * (NWAVES * 64) + ptid, NGT = G * NWAVES * 64;
        float* HS = (float*)(ws + WS_HS);
        for (int i = gt; i < DEPTH * NS * (PW / 4); i += NGT) { const int lb = i / (PW / 4), c4 = i % (PW / 4), w = 2 << (c4 >> 5); f32x4 s = {0.f, 0.f, 0.f, 0.f};
            const float* hp = INP(I_SPOOL) + ((size_t)(lb * PHIST + PHIST)) * PW + 4 * c4;
#pragma unroll
            for (int j0 = 1; j0 < 16; j0 += 5) { if (j0 >= w) break; f32x4 hv[5];
#pragma unroll
                for (int jj = 0; jj < 5; ++jj) { const int j = j0 + jj; hv[jj] = __builtin_nontemporal_load((const f32x4*)(hp - (size_t)((j < w) ? j : 1) * PW)); }
#pragma unroll
                for (int jj = 0; jj < 5; ++jj) { const int j = j0 + jj; if (j < w) s += hv[jj]; } }
            *(f32x4*)(HS + (size_t)lb * PW + 4 * c4) = s; }
#define STATE_COPIES(gt_, ngt_) do { \
        for (int i = (gt_); i < DEPTH * NS * 14 * (PW / 4); i += (ngt_)) { const int lb = i / (14 * (PW / 4)), rem = i % (14 * (PW / 4)), rr = rem / (PW / 4), c4 = rem % (PW / 4); \
            *(f32x4*)(out + O_POOLS + ((size_t)(lb * PHIST + rr)) * PW + 4 * c4) = __builtin_nontemporal_load((const f32x4*)(INP(I_SPOOL) + ((size_t)(lb * PHIST + rr + 1)) * PW + 4 * c4)); } \
        for (int i = (gt_); i < DEPTH * NS * (DFF / 4); i += (ngt_)) { const int lb = i / (DFF / 4), c4 = i % (DFF / 4); \
            *(f32x4*)(out + O_CONVS + ((size_t)(lb * 2)) * DFF + 4 * c4) = __builtin_nontemporal_load((const f32x4*)(INP(I_SCONV) + ((size_t)(lb * 2 + 1)) * DFF + 4 * c4)); } } while (0)
        if (!defer_l1) STATE_COPIES(gt, NGT);
    }
    }
    DBGT(1);
    if (PH(1)) {
        OPAQUE_TID();
        LAS float* scr = (LAS float*)(lds + wave * TR_BYTES);
#define PREP_ITEM(l_, r_) do { const int l = (l_); int r = (r_); bf16* Wl = (bf16*)(ws + WS_W0 + (size_t)l * WS_WSTRIDE); \
            if (r < I_IN) { transpose_item(INP(I_WIN) + (size_t)l * D * NIN, D, NIN, Wl + WO_IN / 2, scr, r, plane, INP(I_N1G) + l * D, nullptr, 0); break; } r -= I_IN; \
            if (r < I_GLU) { transpose_item(INP(I_WGLU) + (size_t)l * SW * 2 * D, SW, 2 * D, Wl + WO_GLU / 2, scr, r, plane, nullptr, nullptr, 1); break; } r -= I_GLU; \
            if (r < I_OUT) { transpose_item(INP(I_WOUT) + (size_t)l * D * D, D, D, Wl + WO_OUT / 2, scr, r, plane, nullptr, nullptr, 0); break; } r -= I_OUT; \
            if (r < I_UP) { transpose_item(INP(I_WUP) + (size_t)l * D * NUP, D, NUP, Wl + WO_UP / 2, scr, r, plane, INP(I_N2G) + l * D, nullptr, 1); break; } r -= I_UP; \
            if (r < 4 * I_PL) { const int grp = r / I_PL; transpose_item(INP(I_POOLW) + ((size_t)(l * 4 + grp)) * 128 * 256, 128, 256, Wl + WO_POOL / 2 + (size_t)grp * 256 * 128, scr, r % I_PL, plane, nullptr, INP(I_POOLSC) + l * D + 256 * grp, 0); break; } r -= 4 * I_PL; \
            transpose_item(INP(I_WDOWN) + (size_t)l * DFF * D, DFF, D, Wl + WO_DOWN / 2, scr, r, plane, nullptr, nullptr, 0); } while (0)
        for (int it = gw; it < (defer_l1 ? NITEMS - I_DOWN : DEPTH * NITEMS); it += NGW) { const int l_ = it / NITEMS; PREP_ITEM(l_, it - l_ * NITEMS); }
        DBGT(2);
        for (int u = bx; u < DEPTH * NG * 4; u += G) { const int l = u / (NG * 4), v = u % (NG * 4); bf16* Tl = (bf16*)(ws + WS_T0 + (size_t)l * WS_TSTRIDE);
            ssm_tables(lds, ptid, l, v >> 2, v & 3, INP(I_ARE), INP(I_AIM), INP(I_LOGDT), INP(I_BRE), INP(I_BIM), INP(I_CRE), INP(I_CIM), INP(I_DSK), Tl + TO_WS / 2, Tl + TO_TOEP / 2, Tl + TO_WY / 2, SMT); }
        DBGT(3);
    }
    GRID_BAR();

#pragma unroll 1
    for (int l = 0; l < DEPTH; ++l) {
        bf16* Wl = (bf16*)(ws + WS_W0 + (size_t)l * WS_WSTRIDE); bf16* Tl = (bf16*)(ws + WS_T0 + (size_t)l * WS_TSTRIDE);
        bf16* WIN = Wl + WO_IN / 2; bf16* WGLU = Wl + WO_GLU / 2; bf16* WOUT = Wl + WO_OUT / 2; bf16* WUP = Wl + WO_UP / 2; bf16* WDOWN = Wl + WO_DOWN / 2; bf16* WPOOL = Wl + WO_POOL / 2;
        bf16* TWS = Tl + TO_WS / 2; bf16* TTOEP = Tl + TO_TOEP / 2; bf16* TWY = Tl + TO_WY / 2;

        if (PH(2))
        {
            pg8::Gemm g{XB, WIN, MMAIN, NIN, D}; pg8::StaticOrder S; S.init(MMAIN, NIN, G, bx); S.strip_base = MMAIN;
            { OPAQUE_TID(); fill_rstd((LAS float*)(lds + RSTD_OFF), RS, RSX, S, ptid); }
            EpiIn E{UPB, USB, GP, GS, (const LAS float*)(lds + RSTD_OFF), out + O_POOLP + (size_t)l * NB * PHIST * PW, out + O_POOLS + (size_t)l * NS * PHIST * PW};
            pg8::gemm_phase<EpiIn, pg8::StaticOrder, true>(lds, lds + XS_OFF, g, S, E);
        }
        GRID_BAR();

        if (PH(3))
        {
            OPAQUE_TID();
            SampleArgs sa{nullptr, nullptr, nullptr, nullptr, nullptr, nullptr, nullptr, nullptr, nullptr, -1, 0};
#ifdef DBG_B
            const unsigned long long tb0_ = __builtin_amdgcn_s_memrealtime();
#endif
            constexpr int NPU = (MMAIN / 256) * 4;
            if (bx & 1) for (int u = bx; u < NPU; u += G) pool_unit(lds, ptid, u >> 2, u & 3, UPB, GP, WPOOL, (const float*)(ws + WS_HS) + (size_t)l * NS * PW);
            for (int u = bx; u < NB * NG; u += G)
                ssm_unit(lds, ptid, l, u >> 5, 4 * (u & 7) + ((u >> 3) & 3), USB, YSB,     TWS, TTOEP, TWY, SMT, out + O_REP + (size_t)l * NB * NG * NST, out + O_IMP + (size_t)l * NB * NG * NST, sa, (l == 0) ? (MISC + 54) : (volatile LAS unsigned*)nullptr);
#ifdef DBG_B
            __syncthreads(); const unsigned long long tb1_ = __builtin_amdgcn_s_memrealtime();
#endif
            if (!(bx & 1)) for (int u = bx; u < NPU; u += G) pool_unit(lds, ptid, u >> 2, u & 3, UPB, GP, WPOOL, (const float*)(ws + WS_HS) + (size_t)l * NS * PW);
            for (int mu = bx; mu < 64 * 4; mu += G) if ((mu & 3) == 0) { const int q = mu >> 2;
                pool_mini8(lds, ptid, MMAIN + 16 * (q >> 2), q & 3, UPB, GP, WPOOL, (const float*)(ws + WS_HS) + (size_t)l * NS * PW); }
            {
                const int nx = NPU - G, skip = (nx > 0 && nx * 2 < G) ? nx : 0;
                if (G == 256) {
                    if ((bx & 3) != 0) { const int pw_ = __builtin_amdgcn_readfirstlane(ptid >> 6); const int wrk = (3 * (bx >> 2) + (bx & 3) - 1) * NWAVES + pw_, g_ = wrk & 31, j_ = wrk >> 5;
                        if (j_ < 32) ssm_sample_items<3>(plane, l, 3 * j_, 1, g_, USB, YSB, SMT, INP(I_BRE), INP(I_BIM), INP(I_CRE), INP(I_CIM), INP(I_DSK), INP(I_SRE), INP(I_SIM), out + O_RES, out + O_IMS);
                        else ssm_sample_items<2>(plane, l, 96 + 2 * (j_ - 32), 1, g_, USB, YSB, SMT, INP(I_BRE), INP(I_BIM), INP(I_CRE), INP(I_CIM), INP(I_DSK), INP(I_SRE), INP(I_SIM), out + O_RES, out + O_IMS); }
                } else
                if (bx >= skip) { const int pw_ = __builtin_amdgcn_readfirstlane(ptid >> 6);
                    const int st_ = (G - skip) * NWAVES;
                    for (int it = (bx - skip) * NWAVES + pw_; it < NS * NG; it += 2 * st_) {
                        if ((st_ & 31) == 0 && it + st_ < NS * NG) ssm_sample_items<2>(plane, l, it >> 5, st_ >> 5, it & 31, USB, YSB, SMT, INP(I_BRE), INP(I_BIM), INP(I_CRE), INP(I_CIM), INP(I_DSK), INP(I_SRE), INP(I_SIM), out + O_RES, out + O_IMS);
                        else { ssm_sample_item(plane, l, it >> 5, it & 31, USB, YSB, SMT, INP(I_BRE), INP(I_BIM), INP(I_CRE), INP(I_CIM), INP(I_DSK), INP(I_SRE), INP(I_SIM), out + O_RES, out + O_IMS);
                            if (it + st_ < NS * NG) ssm_sample_item(plane, l, (it + st_) >> 5, (it + st_) & 31, USB, YSB, SMT, INP(I_BRE), INP(I_BIM), INP(I_CRE), INP(I_CIM), INP(I_DSK), INP(I_SRE), INP(I_SIM), out + O_RES, out + O_IMS); } } }
            }
#ifdef DBG_B
            __syncthreads(); if (l == 0 && threadIdx.x == 0) { const unsigned long long tb2_ = __builtin_amdgcn_s_memrealtime(); MISC[52] = (unsigned)(tb1_ - tb0_); MISC[53] = (unsigned)(tb2_ - tb1_); }
#endif
        }
        GRID_BAR();

        if (PH(4))
        {
            pg8::Gemm g{YSB, WGLU, MMAIN, 2 * D, SW}; pg8::StaticOrder S; S.init(MMAIN, 2 * D, G, bx); S.strip_base = MMAIN;
            EpiGlu E{GP, GS};
            pg8::gemm_phase<EpiGlu, pg8::StaticOrder, true>(lds, lds + XS_OFF, g, S, E);
        }
        GRID_BAR();

        if (PH(5))
        {
            pg8::Gemm g{GP, WOUT, MMAIN, D, D}; pg8::StaticOrder S; S.init(MMAIN, D, G, bx); S.strip_base = MMAIN;
            EpiRes E{XB, RS, RSX};
            pg8::gemm_phase<EpiRes, pg8::StaticOrder, true>(lds, lds + XS_OFF, g, S, E);
        }
        GRID_BAR();

        if (PH(6))
        {
            pg8::Gemm g{XB, WUP, M, NUP, D}; pg8::StaticOrder S; S.init(M, NUP, G, bx); S.swapE = (G == 256) ? 1 : 0;
            { OPAQUE_TID(); fill_rstd((LAS float*)(lds + RSTD_OFF), RS, RSX, S, ptid); }
            EpiUp E{ACT, (const LAS float*)(lds + RSTD_OFF), INP(I_CONVW) + (size_t)l * 3 * DFF, INP(I_CONVB) + (size_t)l * DFF, INP(I_SCONV) + (size_t)l * NS * 2 * DFF,
                    out + O_CONVP + (size_t)l * NB * 2 * DFF, out + O_CONVS + (size_t)l * NS * 2 * DFF, Gtop, Vtop, Gbot, (LAS float*)(lds + XCH_OFF), (LAS float*)(lds + PRM_OFF)};
            pg8::gemm_phase<EpiUp, pg8::StaticOrder, false>(lds, lds + XS_OFF, g, S, E);
            if (l == 1 && defer_l1 && bx >= e_rem) { OPAQUE_TID(); STATE_COPIES((bx - e_rem) * (NWAVES * 64) + ptid, e_idle * NWAVES * 64); }
            if (l == 0 && defer_l1 && bx >= e_rem) {
                OPAQUE_TID(); const int pw_ = __builtin_amdgcn_readfirstlane(ptid >> 6); LAS float* scr = (LAS float*)(lds + pw_ * TR_BYTES);
                for (int it = (bx - e_rem) * NWAVES + pw_; it < NITEMS + I_DOWN; it += e_idle * NWAVES) { if (it < I_DOWN) PREP_ITEM(0, NITEMS - I_DOWN + it); else PREP_ITEM(1, it - I_DOWN); }
            }
        }
        GRID_BAR();

        if (PH(7))
        {
            pg8::Gemm g{ACT, WDOWN, MMAIN, D, DFF}; pg8::StaticOrder S; S.init(MMAIN, D, G, bx); S.strip_base = MMAIN;
            { OPAQUE_TID(); pg8::Unit u; for (int i = 0; S.next(i, u); ++i) for (int pmf = u.pm; pmf >= 0; pmf = (pmf != 64 && S.strip_rows(u) == MMAIN) ? 64 : -1) if (pmf >= 1) act_fixup(ptid, pmf, ACT, INP(I_CONVW) + (size_t)l * 3 * DFF, INP(I_CONVB) + (size_t)l * DFF, Gtop, Vtop, Gbot); }
            VM_WAIT(); __syncthreads();
            if (l == DEPTH - 1 && fuse_final) {
                EpiResFin E{XB, RS, RSX, (unsigned*)(ws + WS_CTL) + CW_FIN, INP(I_NFG), out + O_YP, out + O_YS, (LAS float*)(lds + RSTD_OFF), lds};
                pg8::gemm_phase<EpiResFin, pg8::StaticOrder, true>(lds, lds + XS_OFF, g, S, E);
            } else {
            EpiRes E{XB, RS, RSX};
            pg8::gemm_phase<EpiRes, pg8::StaticOrder, true>(lds, lds + XS_OFF, g, S, E);
            }
        }
        if (!(l == DEPTH - 1 && fuse_final)) GRID_BAR();
    }

#ifdef TMO_CHECK
    {
        const unsigned tmo = __hip_atomic_load((unsigned*)(ws + WS_CTL) + CW_BAR + XB_TMO, __ATOMIC_RELAXED, __HIP_MEMORY_SCOPE_AGENT);
        const unsigned nz = __hip_atomic_load((unsigned*)(ws + WS_CTL) + 8, __ATOMIC_RELAXED, __HIP_MEMORY_SCOPE_AGENT);
        if (tmo != 0u || nz != 0u) { const float val = (nz != 0u) ? 1.0e6f : 1.0e3f; for (int i = bx * 512 + threadIdx.x; i < NS * D; i += G * 512) out[O_YS + i] = val; return; }
    }
#endif
    if (PH(8) && !fuse_final)
    {
    OPAQUE_TID(); const int pgw = bx * NWAVES + __builtin_amdgcn_readfirstlane(ptid >> 6);
    for (int m = pgw; m < M; m += NGW) {
        float* dst;
        if (m < MP) { const int b = m / LSEQ, t = m - b * LSEQ; if (t < NMETA) continue; dst = out + O_YP + ((size_t)(b * SEQ + t - NMETA)) * D; }
        else dst = out + O_YS + (size_t)(m - MP) * D;
        const v2u* s2 = (const v2u*)(XB + (size_t)m * D) + plane; f32x4 v[4]; float ss = 0.f;
#pragma unroll
        for (int j = 0; j < 4; ++j) { const v2u w = s2[64 * j]; v[j] = (f32x4){bflo(w.x), bfhi(w.x), bflo(w.y), bfhi(w.y)}; ss += (v[j].x * v[j].x + v[j].y * v[j].y) + (v[j].z * v[j].z + v[j].w * v[j].w); }
        float rstd = 1.0f / sqrtf(wave_sum(ss) * (1.0f / D) + RMS_EPS);
#if defined(GEMM_DBG) && !defined(DBG_ABS_ONLY)
        if (m >= MP) { const float us = (float)MISC[50] * 0.01f; rstd *= 1.0f + sqrtf(us * 1e-3f); }
#endif
#ifdef TS_I
        if (m >= MP) { const unsigned long long ta = ((unsigned long long)MISC[17 + 2 * (TS_I)] << 32) | MISC[16 + 2 * (TS_I)], tb = ((unsigned long long)MISC[17 + 2 * (TS_J)] << 32) | MISC[16 + 2 * (TS_J)];
            const float us = (float)(tb - ta) * 0.01f; rstd *= 1.0f + sqrtf(us * 1e-3f); }
#endif
        const f32x4* g4 = (const f32x4*)INP(I_NFG) + plane; f32x4* d4 = (f32x4*)dst + plane;
#pragma unroll
        for (int j = 0; j < 4; ++j) __builtin_nontemporal_store(v[j] * rstd * g4[64 * j], d4 + 64 * j);
    }
    }
#ifdef GEMM_DBG
    if (bx == 0 && threadIdx.x == 0) out[O_POOLP] += (float)MISC[51] * 0.01f * 0.01f;
#endif
#ifdef DBG_B
    if (bx == DBG_BLK && threadIdx.x == 0) out[O_POOLP] += (float)MISC[DBG_B] * 0.01f * 0.01f;
#endif
#ifdef DBG_P
    if (bx == 7 && threadIdx.x == 0) out[O_POOLP] += (float)MISC[54 + DBG_P] * 0.01f * 0.01f;
#endif
#ifdef DBG_S
    if (bx == 8 && threadIdx.x == 0) out[O_POOLP] += (float)MISC[54] * 0.01f * 0.1f;
#endif
#ifdef TS2_I
    if (bx == 0 && threadIdx.x == 0) { const unsigned long long ta = ((unsigned long long)MISC[17 + 2 * (TS2_I)] << 32) | MISC[16 + 2 * (TS2_I)], tb = ((unsigned long long)MISC[17 + 2 * (TS2_J)] << 32) | MISC[16 + 2 * (TS2_J)];
        out[O_POOLP] += (float)(tb - ta) * 0.01f * 0.01f; }
#endif
}

extern "C" void kernel_launch(void* const* d_in, const int* in_sizes, int n_in, void* d_out, int out_size, void* d_ws, size_t ws_size, hipStream_t stream) {
    static int grid = 0;
    if (grid == 0) {
        if (n_in != N_IN || (size_t)out_size != O_END || ws_size < WS_END) { fprintf(stderr, "kernel_launch: unexpected shapes: n_in %d out %d ws %zu\n", n_in, out_size, ws_size); grid = -1; return; }
        int dev = 0, cus = 0, per_cu = 0;
        if (hipGetDevice(&dev) != hipSuccess || hipDeviceGetAttribute(&cus, hipDeviceAttributeMultiprocessorCount, dev) != hipSuccess) { grid = -1; return; }
        if (hipFuncSetAttribute((const void*)mk_fwd, hipFuncAttributeMaxDynamicSharedMemorySize, LDS_BYTES) != hipSuccess) { fprintf(stderr, "kernel_launch: hipFuncSetAttribute failed\n"); grid = -1; return; }
        if (hipOccupancyMaxActiveBlocksPerMultiprocessor(&per_cu, (const void*)mk_fwd, NWAVES * 64, LDS_BYTES) != hipSuccess || per_cu < 1) { fprintf(stderr, "kernel_launch: occupancy query says %d blocks per CU\n", per_cu); }
        (void)hipGetLastError();
        grid = cus;
    }
    if (grid < 0) return;
    if (hipMemsetAsync((char*)d_ws + WS_CTL, 0, CTL_ZERO_BYTES, stream) != hipSuccess) { fprintf(stderr, "kernel_launch: memset failed\n"); return; }
    Args a{};
    for (int i = 0; i < N_IN; ++i) a.in[i] = (const float*)d_in[i];
    a.out = (float*)d_out; a.ws = (unsigned char*)d_ws; a.pad = 0ull;
    hipLaunchKernelGGL(mk_fwd, dim3(grid), dim3(NWAVES * 64), LDS_BYTES, stream, a);
    const hipError_t le = hipPeekAtLastError();
    if (le != hipSuccess) fprintf(stderr, "kernel_launch: launch failed: %s\n", hipGetErrorName(le));
}
```
